# Optimizing an MI355X kernel written in HIP

```python
import math
import jax, jax.numpy as jnp
from jax import lax
import numpy as np

D_MODEL = 1024
BATCH = 16
SEQ = 2048
DEPTH = 1
DEC_BATCH = 32
DEC_SEQ = 32
PAST_LEN = 4096

CHUNK = 64
Q_BLOCK = 128
DIFF_HEADS = 4
HEAD_DIM = 64
DIFF_WIDTH = DIFF_HEADS * 2 * HEAD_DIM
GMLP_GROUPS = 4
GMLP_CHUNK = 128
GMLP_GROUP_DIM = 128
GMLP_WIDTH = GMLP_GROUPS * GMLP_GROUP_DIM
MIX_WIDTH = DIFF_WIDTH + GMLP_WIDTH
IN_COLS = 3 * DIFF_WIDTH + 2 * GMLP_WIDTH
D_FF = 2816
N_MEM = 256
MEM_HEADS = 4
MEM_HEAD_DIM = D_MODEL // MEM_HEADS
LN_EPS = 1e-5
ALPHA = (2 * DEPTH) ** 0.25
BETA = (8 * DEPTH) ** -0.25

kernel_name = "hybrid_diffattn_gmlp_macaron_deepnorm_stream_step"

F32 = jnp.float32


def layer_norm(h, g, b):
    h32 = h.astype(F32)
    mu = jnp.mean(h32, axis=-1, keepdims=True)
    var = jnp.mean(jnp.square(h32 - mu), axis=-1, keepdims=True)
    return ((h32 - mu) * lax.rsqrt(var + LN_EPS) * g.astype(F32) + b.astype(F32)).astype(h.dtype)


def post_norm(x, h, g, b):
    return layer_norm(ALPHA * x + h, g, b)


def swiglu_half(x, w_gu, w_down):
    gate, up = jnp.split(x @ w_gu, 2, axis=-1)
    return 0.5 * ((jax.nn.silu(gate) * up) @ w_down)


def lambda_init_for(layer_idx):
    return 0.8 - 0.6 * math.exp(-0.3 * layer_idx)


def diff_lambda(lq1, lk1, lq2, lk2, lam_init):
    return (jnp.exp(jnp.sum(lq1.astype(F32) * lk1.astype(F32)))
            - jnp.exp(jnp.sum(lq2.astype(F32) * lk2.astype(F32))) + lam_init)


def alibi_slopes():
    return jnp.exp2(-8.0 * jnp.arange(1, DIFF_HEADS + 1, dtype=F32) / DIFF_HEADS)


def diff_attention(q, k, v, q_start, lam):
    B, T = q.shape[0], q.shape[1]
    S = k.shape[1]
    qb = min(Q_BLOCK, T)
    nb = T // qb
    k_pos = jnp.arange(S, dtype=jnp.int32)
    slopes = alibi_slopes()
    scale = HEAD_DIM ** -0.5

    def block(args):
        q_blk, start = args
        q_pos = start + jnp.arange(qb, dtype=jnp.int32)
        s = jnp.einsum('bqhmd,bkhmd->bhmqk', q_blk, k).astype(F32) * scale
        dist = jnp.abs(q_pos[:, None] - k_pos[None, :]).astype(F32)
        allowed = (k_pos[None, :] // CHUNK) <= (q_pos[:, None] // CHUNK)
        s = s - slopes[None, :, None, None, None] * dist[None, None, None]
        s = jnp.where(allowed, s, -jnp.inf)
        p = jax.nn.softmax(s, axis=-1)
        a = p[:, :, 0] - lam * p[:, :, 1]
        return jnp.einsum('bhqk,bkhe->bqhe', a.astype(v.dtype), v)

    q_blocks = jnp.moveaxis(q.reshape(B, nb, qb, DIFF_HEADS, 2, HEAD_DIM), 1, 0)
    starts = q_start + qb * jnp.arange(nb, dtype=jnp.int32)
    out = lax.map(block, (q_blocks, starts))
    return jnp.moveaxis(out, 0, 1).reshape(B, T, DIFF_HEADS, 2 * HEAD_DIM)


def spatial_gating(u, v, ln_g, ln_b, ws, bs):
    B, T, _ = u.shape
    n = min(T, GMLP_CHUNK)
    nc = T // n
    v = layer_norm(v, ln_g, ln_b)
    vg = v.reshape(B, nc, n, GMLP_GROUPS, GMLP_GROUP_DIM)
    w = ws[:, :n, :n] * jnp.tril(jnp.ones((n, n), ws.dtype))
    mixed = jnp.einsum('gts,bcsgd->bctgd', w, vg) + bs[:, :n].T[None, None, :, :, None]
    out = u * mixed.reshape(B, T, GMLP_WIDTH)
    return out, vg.reshape(B, T, GMLP_GROUPS, GMLP_GROUP_DIM)


def cross_attention(x, mem_k, mem_v, wq, wo):
    B, T, _ = x.shape
    q = (x @ wq).reshape(B, T, MEM_HEADS, MEM_HEAD_DIM)
    s = jnp.einsum('bthd,bmhd->bhtm', q, mem_k).astype(F32) * (MEM_HEAD_DIM ** -0.5)
    p = jax.nn.softmax(s, axis=-1)
    o = jnp.einsum('bhtm,bmhd->bthd', p.astype(mem_v.dtype), mem_v).reshape(B, T, D_MODEL)
    return o @ wo


def trunk_layer(x, k_past, v_past, mem_k, mem_v, layer_idx, p):
    B, T, _ = x.shape
    x = post_norm(x, swiglu_half(x, p['ffn1_w_gu'], p['ffn1_w_down']), p['ln1_g'], p['ln1_b'])

    z = x @ p['w_in']
    q, k, v, gu, gv = jnp.split(
        z, [DIFF_WIDTH, 2 * DIFF_WIDTH, 3 * DIFF_WIDTH, 3 * DIFF_WIDTH + GMLP_WIDTH], axis=-1)
    q = q.reshape(B, T, DIFF_HEADS, 2, HEAD_DIM)
    k = k.reshape(B, T, DIFF_HEADS, 2, HEAD_DIM)
    v = v.reshape(B, T, DIFF_HEADS, 2 * HEAD_DIM)
    if k_past is None:
        q_start, k_all, v_all = 0, k, v
    else:
        q_start = k_past.shape[1]
        k_all = jnp.concatenate([k_past, k], axis=1)
        v_all = jnp.concatenate([v_past, v], axis=1)

    lam_init = lambda_init_for(layer_idx)
    lam = diff_lambda(p['lambda_q1'], p['lambda_k1'], p['lambda_q2'], p['lambda_k2'], lam_init)
    a = diff_attention(q, k_all, v_all, q_start, lam)
    a32 = a.astype(F32)
    a32 = a32 * lax.rsqrt(jnp.mean(jnp.square(a32), axis=-1, keepdims=True) + LN_EPS)
    a = (a32 * p['subln_g'].astype(F32) * (1.0 - lam_init)).astype(x.dtype).reshape(B, T, DIFF_WIDTH)

    g_out, v_rows = spatial_gating(jax.nn.gelu(gu), jax.nn.gelu(gv), p['gmlp_ln_g'], p['gmlp_ln_b'],
                                   p['gmlp_ws'], p['gmlp_bs'])

    mix = jnp.concatenate([a, g_out], axis=-1) @ p['w_out']
    x = post_norm(x, mix, p['ln2_g'], p['ln2_b'])
    x = post_norm(x, cross_attention(x, mem_k, mem_v, p['cross_wq'], p['cross_wo']), p['ln3_g'], p['ln3_b'])
    x = post_norm(x, swiglu_half(x, p['ffn2_w_gu'], p['ffn2_w_down']), p['ln4_g'], p['ln4_b'])
    return x, k, v, v_rows


def setup_inputs(seed: int = 0) -> dict:
    key = jax.random.key(seed)
    ks = iter(jax.random.split(key, 48))

    def nrm(shape, scale):
        return jax.random.normal(next(ks), shape, F32) * scale

    def gain(shape):
        return 1.0 + nrm(shape, 0.01)

    L = DEPTH
    return {
        "x_prompt": nrm((BATCH, SEQ, D_MODEL), 1.0),
        "x_sample": nrm((DEC_BATCH, DEC_SEQ, D_MODEL), 1.0),
        "cache_k": nrm((L, DEC_BATCH, PAST_LEN, DIFF_HEADS, 2, HEAD_DIM), 1.0),
        "cache_v": nrm((L, DEC_BATCH, PAST_LEN, DIFF_HEADS, 2 * HEAD_DIM), 1.0),
        "cache_mem_k": nrm((L, DEC_BATCH, N_MEM, MEM_HEADS, MEM_HEAD_DIM), 1.0),
        "cache_mem_v": nrm((L, DEC_BATCH, N_MEM, MEM_HEADS, MEM_HEAD_DIM), 1.0),
        "mem_prompt": nrm((BATCH, N_MEM, D_MODEL), 1.0),
        "ffn1_w_gu": nrm((L, D_MODEL, 2 * D_FF), D_MODEL ** -0.5),
        "ffn1_w_down": nrm((L, D_FF, D_MODEL), BETA * D_FF ** -0.5),
        "ln1_g": gain((L, D_MODEL)),
        "ln1_b": nrm((L, D_MODEL), 0.01),
        "w_in": nrm((L, D_MODEL, IN_COLS), D_MODEL ** -0.5),
        "lambda_q1": nrm((L, HEAD_DIM), 0.1),
        "lambda_k1": nrm((L, HEAD_DIM), 0.1),
        "lambda_q2": nrm((L, HEAD_DIM), 0.1),
        "lambda_k2": nrm((L, HEAD_DIM), 0.1),
        "subln_g": gain((L, 2 * HEAD_DIM)),
        "gmlp_ln_g": gain((L, GMLP_WIDTH)),
        "gmlp_ln_b": nrm((L, GMLP_WIDTH), 0.01),
        "gmlp_ws": nrm((L, GMLP_GROUPS, GMLP_CHUNK, GMLP_CHUNK), 0.05),
        "gmlp_bs": gain((L, GMLP_GROUPS, GMLP_CHUNK)),
        "w_out": nrm((L, MIX_WIDTH, D_MODEL), BETA * MIX_WIDTH ** -0.5),
        "ln2_g": gain((L, D_MODEL)),
        "ln2_b": nrm((L, D_MODEL), 0.01),
        "cross_wq": nrm((L, D_MODEL, D_MODEL), D_MODEL ** -0.5),
        "cross_wk": nrm((L, D_MODEL, D_MODEL), D_MODEL ** -0.5),
        "cross_wv": nrm((L, D_MODEL, D_MODEL), D_MODEL ** -0.5),
        "cross_wo": nrm((L, D_MODEL, D_MODEL), BETA * D_MODEL ** -0.5),
        "ln3_g": gain((L, D_MODEL)),
        "ln3_b": nrm((L, D_MODEL), 0.01),
        "ffn2_w_gu": nrm((L, D_MODEL, 2 * D_FF), D_MODEL ** -0.5),
        "ffn2_w_down": nrm((L, D_FF, D_MODEL), BETA * D_FF ** -0.5),
        "ln4_g": gain((L, D_MODEL)),
        "ln4_b": nrm((L, D_MODEL), 0.01),
    }


def reference(x_prompt, x_sample, cache_k, cache_v, cache_mem_k, cache_mem_v, mem_prompt,
              ffn1_w_gu, ffn1_w_down, ln1_g, ln1_b, w_in, lambda_q1, lambda_k1, lambda_q2, lambda_k2,
              subln_g, gmlp_ln_g, gmlp_ln_b, gmlp_ws, gmlp_bs, w_out, ln2_g, ln2_b,
              cross_wq, cross_wk, cross_wv, cross_wo, ln3_g, ln3_b,
              ffn2_w_gu, ffn2_w_down, ln4_g, ln4_b):
    xp, xs = x_prompt, x_sample
    Bp = mem_prompt.shape[0]
    kp_l, vp_l, mkp_l, mvp_l, ks_l, vs_l, gvs_l = [], [], [], [], [], [], []
    for l in range(DEPTH):
        p = {
            'ffn1_w_gu': ffn1_w_gu[l], 'ffn1_w_down': ffn1_w_down[l], 'ln1_g': ln1_g[l], 'ln1_b': ln1_b[l],
            'w_in': w_in[l], 'lambda_q1': lambda_q1[l], 'lambda_k1': lambda_k1[l],
            'lambda_q2': lambda_q2[l], 'lambda_k2': lambda_k2[l], 'subln_g': subln_g[l],
            'gmlp_ln_g': gmlp_ln_g[l], 'gmlp_ln_b': gmlp_ln_b[l], 'gmlp_ws': gmlp_ws[l], 'gmlp_bs': gmlp_bs[l],
            'w_out': w_out[l], 'ln2_g': ln2_g[l], 'ln2_b': ln2_b[l],
            'cross_wq': cross_wq[l], 'cross_wo': cross_wo[l], 'ln3_g': ln3_g[l], 'ln3_b': ln3_b[l],
            'ffn2_w_gu': ffn2_w_gu[l], 'ffn2_w_down': ffn2_w_down[l], 'ln4_g': ln4_g[l], 'ln4_b': ln4_b[l],
        }
        mem_k = (mem_prompt @ cross_wk[l]).reshape(Bp, N_MEM, MEM_HEADS, MEM_HEAD_DIM)
        mem_v = (mem_prompt @ cross_wv[l]).reshape(Bp, N_MEM, MEM_HEADS, MEM_HEAD_DIM)
        xp, kp, vp, _ = trunk_layer(xp, None, None, mem_k, mem_v, l, p)
        xs, ks_new, vs_new, gv_new = trunk_layer(xs, cache_k[l], cache_v[l], cache_mem_k[l], cache_mem_v[l], l, p)
        kp_l.append(kp); vp_l.append(vp); mkp_l.append(mem_k); mvp_l.append(mem_v)
        ks_l.append(ks_new); vs_l.append(vs_new); gvs_l.append(gv_new)
    new_k_prompt = jnp.stack(kp_l)
    new_v_prompt = jnp.stack(vp_l)
    new_mem_k_prompt = jnp.stack(mkp_l)
    new_mem_v_prompt = jnp.stack(mvp_l)
    new_k_sample = jnp.stack(ks_l)
    new_v_sample = jnp.stack(vs_l)
    new_gmlp_v_sample = jnp.stack(gvs_l)
    return (xp, xs, new_k_prompt, new_v_prompt, new_mem_k_prompt, new_mem_v_prompt,
            new_k_sample, new_v_sample, new_gmlp_v_sample)
```

```cpp
#include <hip/hip_runtime.h>
#include <hip/hip_cooperative_groups.h>
#include <cstdio>
#include <cstdint>
namespace cg = cooperative_groups;

#ifndef ONE_LAUNCH
#define ONE_LAUNCH 1
#endif

#define LAS __attribute__((address_space(3)))
#define GASP __attribute__((address_space(1)))
typedef unsigned short bf16_t;
typedef short bf16x8 __attribute__((ext_vector_type(8)));
typedef short s16x4 __attribute__((ext_vector_type(4)));
typedef short v4i16_t __attribute__((ext_vector_type(4)));
typedef float f32x2 __attribute__((ext_vector_type(2)));
typedef float f32x4 __attribute__((ext_vector_type(4)));
typedef float f32x16 __attribute__((ext_vector_type(16)));
typedef unsigned u32x2 __attribute__((ext_vector_type(2)));
typedef unsigned u32x4 __attribute__((ext_vector_type(4)));

constexpr int D = 1024, NP = 32768, NS = 1024, M = NP + NS, SEQ = 2048, PAST = 4096, DECS = 32;
constexpr int FF = 2816, INC = 2560;
constexpr float LN_EPS = 1e-5f, ALPHA = 1.189207115002721f, LOG2E = 1.4426950408889634f;
constexpr int NPH = 17;
#ifndef PH_MASK
#define PH_MASK 0x1ffff
#endif
#define PH_ON(k) (((PH_MASK) >> (k)) & 1)
#ifndef REP5
#define REP5 0
#endif
#ifndef REP12
#define REP12 0
#endif
#ifndef REP0
#define REP0 0
#endif
#ifndef EXPER5
#define EXPER5 0
#endif
#ifndef REP9
#define REP9 0
#endif
#ifndef REP5_PARTS
#define REP5_PARTS 7
#endif

constexpr size_t OUT_Y = 0, OUT_KP = 34603008, OUT_VP = 51380224, OUT_MK = 68157440, OUT_MV = 72351744, OUT_KS = 76546048, OUT_VS = 77070336, OUT_GV = 77594624;

constexpr size_t O_CTR = 0;
constexpr size_t O_WGU1 = 4096;
constexpr size_t O_WDN1 = O_WGU1 + (size_t)2 * FF * D * 2;
constexpr size_t O_WIN = O_WDN1 + (size_t)D * FF * 2;
constexpr size_t O_WOUT = O_WIN + (size_t)INC * D * 2;
constexpr size_t O_WQ = O_WOUT + (size_t)D * D * 2;
constexpr size_t O_WKV = O_WQ + (size_t)D * D * 2;
constexpr size_t O_WO = O_WKV + (size_t)2 * D * D * 2;
constexpr size_t O_WGU2 = O_WO + (size_t)D * D * 2;
constexpr size_t O_WDN2 = O_WGU2 + (size_t)2 * FF * D * 2;
constexpr size_t O_WSB = O_WDN2 + (size_t)D * FF * 2;
constexpr size_t O_XB = O_WSB + 4 * 128 * 128 * 2;
constexpr size_t O_XF = O_XB + (size_t)M * D * 2;
constexpr size_t O_ACT = O_XF + (size_t)M * D * 4;
constexpr size_t O_MEMB = O_ACT + (size_t)M * FF * 2;
constexpr size_t O_MKB = O_MEMB + (size_t)4096 * D * 2;
constexpr size_t O_MVB = O_MKB + (size_t)48 * 256 * D * 2;
constexpr size_t O_QB = O_MVB + (size_t)48 * 256 * D * 2;
constexpr size_t O_KB = O_QB + (size_t)M * 512 * 2;
constexpr size_t O_VB = O_KB + (size_t)M * 512 * 2;
constexpr size_t O_UB = O_VB + (size_t)M * 512 * 2;
constexpr size_t O_GVF = O_UB + (size_t)M * 512 * 2;
constexpr size_t O_MIX = O_GVF + (size_t)M * 512 * 4;
constexpr size_t O_ST1 = O_MIX + (size_t)M * D * 2;
constexpr size_t O_ST2 = O_ST1 + (size_t)M * 128;
constexpr size_t O_ST3 = O_ST2 + (size_t)M * 128;
constexpr int NC12 = INC + D + 2 * FF;
constexpr int C_IN = 0, C_Q = INC, C_GU2 = INC + D;
constexpr size_t O_C1P = O_ST3 + (size_t)M * 128;
constexpr size_t O_C2P = O_C1P + (size_t)16 * NC12 * 4;
constexpr size_t O_C1 = O_C2P + (size_t)16 * NC12 * 4;
constexpr size_t O_C2 = O_C1 + (size_t)NC12 * 4;
constexpr size_t O_GST = O_C2 + (size_t)NC12 * 4;
constexpr size_t O_BAR = O_GST + (size_t)M * 64;
constexpr size_t O_SLAB = O_BAR + 16384;
constexpr size_t O_END = O_SLAB + (size_t)11 * NS * D * 4;
constexpr size_t O_QC = O_ACT, O_OC = O_ACT + (size_t)M * D * 2;

constexpr int LDS_BYTES = 147456;
constexpr int LDS_CTL = 144 * 1024 - 256;

struct Params { const float* in[34]; float* out; unsigned char* ws; int ph_lo, ph_hi; };

__device__ __forceinline__ unsigned pk2(float lo, float hi) {
    typedef __bf16 b2 __attribute__((ext_vector_type(2)));
    f32x2 v = {lo, hi}; b2 b = __builtin_convertvector(v, b2); return __builtin_bit_cast(unsigned, b);
}
__device__ __forceinline__ float wave_sum(float v) {
#pragma unroll
    for (int o = 1; o < 64; o <<= 1) v += __shfl_xor(v, o);
    return v;
}
__device__ __forceinline__ float fexp2(float x) { return __builtin_amdgcn_exp2f(x); }
__device__ __forceinline__ float frcp(float x) { return __builtin_amdgcn_rcpf(x); }
__device__ __forceinline__ float silu_f(float g) { return g * frcp(1.f + fexp2(-g * LOG2E)); }
__device__ __forceinline__ float gelu_f(float x) { const float u = 0.7978845608028654f * (x + 0.044715f * x * x * x); return x * frcp(1.f + fexp2(-2.f * LOG2E * u)); }

namespace pg8 {
constexpr int BM = 256, BK = 64, HALF = 128, HTB = HALF * BK * 2, STAGE_BYTES = 8 * HTB, NXCD = 8, WGM = 8;
__host__ __device__ __forceinline__ int lds_byte(int r, int c) { const int st = (r >> 4) * 2 + (c >> 5), rr = r & 15, cc = c & 31, ob = rr * 64 + cc * 2; return st * 1024 + (ob ^ (((ob >> 9) & 1) << 5)); }
__host__ __device__ __forceinline__ void stage_rc(int b, int& R, int& C) { const int st = b / 1024, sb = b % 1024, swz = sb ^ (((sb >> 9) & 1) << 5); R = (st >> 1) * 16 + swz / 64; C = (st & 1) * 32 + (swz % 64) / 2; }
__host__ __device__ __forceinline__ int perm32(int rho) { const int n = rho >> 4, i = rho & 15; return 8 * (i >> 2) + 4 * n + (i & 3); }
struct Unit { int pm, pn, kofs; };
struct Gemm { const bf16_t* A; const bf16_t* Bt; int M, N, K; int ldk; };
struct StaticOrder {
    int nM, nN, nwg, G, c;
    __host__ __device__ void init(int M_, int N_, int G_, int c_) { nM = M_ / BM; nN = N_ / BM; nwg = nM * nN; G = G_; c = c_; }
    __host__ __device__ bool next(int i, Unit& u) const {
        const long L = (long)i * G + c; if (L >= nwg) return false;
        int wgid = (int)L; { const int q = nwg / NXCD, r = nwg % NXCD, xcd = wgid % NXCD, off = wgid / NXCD; wgid = (xcd < r ? xcd * (q + 1) : r * (q + 1) + (xcd - r) * q) + off; }
        const int nig = WGM * nN, gid = wgid / nig, fm = gid * WGM, gsz = (nM - fm) < WGM ? (nM - fm) : WGM;
        u.pm = fm + ((wgid % nig) % gsz); u.pn = (wgid % nig) / gsz; u.kofs = 0; return true;
    }
};
template <class Epi, class Sched, bool ALIGN_EPI = false, bool SP2 = false>
__device__ __forceinline__ void gemm_phase(LAS unsigned char* lds, const Gemm g, const Sched& S, const Epi& E) {
    int tid = threadIdx.x; asm volatile("" : "+v"(tid));
    const int wid = __builtin_amdgcn_readfirstlane(tid >> 6), lane = tid & 63, wr = wid >> 2, wc = wid & 3, fr = lane & 15, fq = lane >> 4;
    const int K = g.ldk, nt = g.K / BK;
    unsigned voffA[2], voffB[2];
#pragma unroll
    for (int i = 0; i < 2; ++i) { int R, C; stage_rc(tid * 16 + i * 8192, R, C); const int Rb = Epi::PERM ? ((R & ~31) + perm32(R & 31)) : R;
        voffA[i] = (unsigned)(R * K + C) * 2u; voffB[i] = (unsigned)(Rb * K + C) * 2u; }
    const size_t kstep = (size_t)(BK * 2);
    const size_t hstep = (size_t)HALF * K * 2;
    const size_t tstep = 2 * hstep;
    const unsigned ldsw = (unsigned)wid * 1024u;
    const int aoff = lds_byte(wr * 64 + fr, fq * 8), boff = lds_byte(wc * 32 + fr, fq * 8);
#define PG8_SA(b, h) (((b) * 2 + (h)) * HTB)
#define PG8_SB(b, h) ((4 + (b) * 2 + (h)) * HTB)
#define PG8_STAGE(bufoff, gbase, voff) do { _Pragma("unroll") for (int _i = 0; _i < 2; ++_i) \
        __builtin_amdgcn_global_load_lds((const unsigned*)((const char*)(gbase) + (voff)[_i]), (LAS unsigned*)(lds + (bufoff) + ldsw + _i * 8192), 16, 0, 0); } while (0)
#define PG8_LDA(dst, b, h) do { _Pragma("unroll") for (int m = 0; m < 4; ++m) _Pragma("unroll") for (int k = 0; k < 2; ++k) dst[m][k] = *(const LAS bf16x8*)(lds + PG8_SA(b, h) + aoff + m * 2048 + k * 1024); } while (0)
#define PG8_LDB(dst, b, h) do { _Pragma("unroll") for (int n = 0; n < 2; ++n) _Pragma("unroll") for (int k = 0; k < 2; ++k) dst[n][k] = *(const LAS bf16x8*)(lds + PG8_SB(b, h) + boff + n * 2048 + k * 1024); } while (0)
#define PG8_MMA(ai, bj, At, Bt) do { __builtin_amdgcn_s_setprio(1); _Pragma("unroll") for (int m = 0; m < 4; ++m) _Pragma("unroll") for (int n = 0; n < 2; ++n) _Pragma("unroll") for (int k = 0; k < 2; ++k) \
        acc[ai][bj][m][n] = __builtin_amdgcn_mfma_f32_16x16x32_bf16(Bt[n][k], At[m][k], acc[ai][bj][m][n], 0, 0, 0); __builtin_amdgcn_s_setprio(0); } while (0)
#define PG8_WAIT_V(n) asm volatile("s_waitcnt vmcnt(" #n ")" ::: "memory")
#define PG8_WAIT_L(n) asm volatile("s_waitcnt lgkmcnt(" #n ")" ::: "memory")
#define PG8_BAR __builtin_amdgcn_s_barrier()
#define PG8_SCHED __builtin_amdgcn_sched_barrier(0)
    Unit cur, nxt; int ui = 0;
    if (!S.next(0, cur)) return;
    f32x4 acc[2][2][4][2];
#pragma unroll
    for (int a = 0; a < 2; ++a)
#pragma unroll
        for (int b = 0; b < 2; ++b)
#pragma unroll
            for (int m = 0; m < 4; ++m)
#pragma unroll
                for (int n = 0; n < 2; ++n) acc[a][b][m][n] = (f32x4){0.f, 0.f, 0.f, 0.f};
    bf16x8 At[4][2], B0[2][2], B1[2][2];
    const char* cA = (const char*)g.A + (size_t)cur.pm * tstep + (size_t)cur.kofs * 2; const char* cB = (const char*)g.Bt + (size_t)cur.pn * tstep + (size_t)cur.kofs * 2;
    if constexpr (SP2) {
        PG8_STAGE(PG8_SB(0, 0), cB, voffB); PG8_STAGE(PG8_SB(0, 1), cB + hstep, voffB); PG8_STAGE(PG8_SA(0, 0), cA, voffA); PG8_STAGE(PG8_SA(0, 1), cA + hstep, voffA);
        if (wr == 1) PG8_BAR;
        PG8_WAIT_V(2); PG8_BAR;
        PG8_STAGE(PG8_SB(1, 0), cB + kstep, voffB); PG8_STAGE(PG8_SA(1, 0), cA + kstep, voffA); PG8_STAGE(PG8_SB(1, 1), cB + hstep + kstep, voffB);
        PG8_WAIT_V(6); PG8_BAR;
    } else {
        PG8_STAGE(PG8_SB(0, 0), cB, voffB); PG8_STAGE(PG8_SA(0, 0), cA, voffA); PG8_STAGE(PG8_SB(0, 1), cB + hstep, voffB); PG8_STAGE(PG8_SA(0, 1), cA + hstep, voffA);
        if (wr == 1) PG8_BAR;
        PG8_WAIT_V(4); PG8_BAR;
        PG8_STAGE(PG8_SB(1, 0), cB + kstep, voffB); PG8_STAGE(PG8_SA(1, 0), cA + kstep, voffA); PG8_STAGE(PG8_SB(1, 1), cB + hstep + kstep, voffB);
        PG8_WAIT_V(6); PG8_BAR;
    }
    for (;;) {
        const bool has_next = S.next(ui + 1, nxt);
        const char* nA = has_next ? (const char*)g.A + (size_t)nxt.pm * tstep + (size_t)nxt.kofs * 2 : cA; const char* nB = has_next ? (const char*)g.Bt + (size_t)nxt.pn * tstep + (size_t)nxt.kofs * 2 : cB;
        for (int t = 0; t < nt; t += 2) {
            const bool last = (t == nt - 2);
            const char* a1 = cA + (size_t)(t + 1) * kstep;
            const char* a2 = last ? nA : cA + (size_t)(t + 2) * kstep; const char* b2 = last ? nB : cB + (size_t)(t + 2) * kstep;
            const char* a3 = a2 + kstep; const char* b3 = b2 + kstep;
            if constexpr (SP2) {
            PG8_LDB(B0, 0, 0); PG8_LDB(B1, 0, 1); PG8_SCHED; PG8_LDA(At, 0, 0); PG8_STAGE(PG8_SA(1, 1), a1 + hstep, voffA);
            PG8_WAIT_V(8); PG8_WAIT_L(0); PG8_BAR; PG8_MMA(0, 0, At, B0); PG8_MMA(0, 1, At, B1); PG8_BAR; PG8_SCHED;
            PG8_LDA(At, 0, 1); PG8_STAGE(PG8_SB(0, 0), b2, voffB); PG8_STAGE(PG8_SB(0, 1), b2 + hstep, voffB); PG8_STAGE(PG8_SA(0, 0), a2, voffA);
            PG8_WAIT_V(8); PG8_WAIT_L(0); PG8_BAR; PG8_MMA(1, 0, At, B0); PG8_MMA(1, 1, At, B1); PG8_BAR; PG8_SCHED;
            PG8_LDB(B0, 1, 0); PG8_LDB(B1, 1, 1); PG8_SCHED; PG8_LDA(At, 1, 0); PG8_STAGE(PG8_SA(0, 1), a2 + hstep, voffA);
            PG8_WAIT_V(8); PG8_WAIT_L(0); PG8_BAR; PG8_MMA(0, 0, At, B0); PG8_MMA(0, 1, At, B1); PG8_BAR; PG8_SCHED;
            PG8_LDA(At, 1, 1); PG8_STAGE(PG8_SB(1, 0), b3, voffB); PG8_STAGE(PG8_SB(1, 1), b3 + hstep, voffB); PG8_STAGE(PG8_SA(1, 0), a3, voffA);
            PG8_WAIT_V(8); PG8_WAIT_L(0); PG8_BAR; PG8_MMA(1, 0, At, B0); PG8_MMA(1, 1, At, B1); PG8_BAR; PG8_SCHED;
            } else {
            PG8_LDB(B0, 0, 0); PG8_SCHED; PG8_LDA(At, 0, 0); PG8_STAGE(PG8_SA(1, 1), a1 + hstep, voffA);
            PG8_WAIT_L(8); PG8_BAR; PG8_WAIT_L(0); PG8_MMA(0, 0, At, B0); PG8_BAR; PG8_SCHED;
            PG8_LDB(B1, 0, 1); PG8_STAGE(PG8_SB(0, 0), b2, voffB);
            PG8_BAR; PG8_WAIT_L(0); PG8_MMA(0, 1, At, B1); PG8_BAR;
            PG8_LDA(At, 0, 1); PG8_STAGE(PG8_SA(0, 0), a2, voffA);
            PG8_BAR; PG8_WAIT_L(0); PG8_MMA(1, 0, At, B0); PG8_BAR; PG8_SCHED;
            PG8_STAGE(PG8_SB(0, 1), b2 + hstep, voffB);
            PG8_WAIT_V(6); PG8_BAR; PG8_MMA(1, 1, At, B1); PG8_BAR;
            PG8_LDB(B0, 1, 0); PG8_SCHED; PG8_LDA(At, 1, 0); PG8_STAGE(PG8_SA(0, 1), a2 + hstep, voffA);
            PG8_WAIT_L(8); PG8_BAR; PG8_WAIT_L(0); PG8_MMA(0, 0, At, B0); PG8_BAR; PG8_SCHED;
            PG8_LDB(B1, 1, 1); PG8_STAGE(PG8_SB(1, 0), b3, voffB);
            PG8_BAR; PG8_WAIT_L(0); PG8_MMA(0, 1, At, B1); PG8_BAR;
            PG8_LDA(At, 1, 1); PG8_STAGE(PG8_SA(1, 0), a3, voffA);
            PG8_BAR; PG8_WAIT_L(0); PG8_MMA(1, 0, At, B0); PG8_BAR; PG8_SCHED;
            PG8_STAGE(PG8_SB(1, 1), b3 + hstep, voffB);
            PG8_WAIT_V(6); PG8_BAR; PG8_MMA(1, 1, At, B1); PG8_BAR;
            }
        }
        if constexpr (ALIGN_EPI) { if (wr == 0) PG8_BAR; }
        E(acc, cur, wr, wc, fr, fq, lds);
        if (!has_next) break;
#pragma unroll
        for (int a = 0; a < 2; ++a)
#pragma unroll
            for (int b = 0; b < 2; ++b)
#pragma unroll
                for (int m = 0; m < 4; ++m)
#pragma unroll
                    for (int n = 0; n < 2; ++n) acc[a][b][m][n] = (f32x4){0.f, 0.f, 0.f, 0.f};
        cur = nxt; cA = nA; cB = nB; ++ui;
        if constexpr (ALIGN_EPI) { if (wr == 1) PG8_BAR; }
    }
    PG8_WAIT_V(0);
    if constexpr (!ALIGN_EPI) { if (wr == 0) PG8_BAR; }
    PG8_BAR;
#undef PG8_SA
#undef PG8_SB
#undef PG8_STAGE
#undef PG8_LDA
#undef PG8_LDB
#undef PG8_MMA
#undef PG8_WAIT_V
#undef PG8_WAIT_L
#undef PG8_BAR
#undef PG8_SCHED
}

typedef f32x4 Acc[2][2][4][2];
constexpr int SL_OFF = STAGE_BYTES;
__device__ __forceinline__ void row_stats_table(LAS unsigned char* lds, const float* ST, int pm) {
    const int tid = threadIdx.x;
    if (tid < 256) { const GASP f32x4* sp = (const GASP f32x4*)(ST + (size_t)(pm * BM + tid) * 32); float s = 0.f, q = 0.f;
#pragma unroll
        for (int i = 0; i < 8; ++i) { const f32x4 v = sp[i]; s += v[0] + v[2]; q += v[1] + v[3]; }
        const float mu = s * (1.f / D), var = q * (1.f / D) - mu * mu;
        ((LAS f32x2*)(lds + SL_OFF))[tid] = (f32x2){mu, 1.f / sqrtf(var + LN_EPS)}; }
    asm volatile("s_waitcnt lgkmcnt(0)" ::: "memory"); __builtin_amdgcn_s_barrier(); asm volatile("" ::: "memory");
}
template <bool PERM>
__device__ __forceinline__ void ln_fold_fix(Acc& acc, const Unit& u, int wr, int wc, int fr, int fq, const float* c1, const float* c2, LAS unsigned char* lds) {
    const LAS f32x2* SL = (const LAS f32x2*)(lds + SL_OFF);
#pragma unroll
    for (int bj = 0; bj < 2; ++bj)
#pragma unroll
        for (int n = 0; n < 2; ++n) { const int c = u.pn * BM + bj * HALF + wc * 32 + (PERM ? 8 * fq + 4 * n : 16 * n + 4 * fq);
            const f32x4 a1 = *(const GASP f32x4*)(c1 + c), a2 = *(const GASP f32x4*)(c2 + c);
#pragma unroll
            for (int ai = 0; ai < 2; ++ai)
#pragma unroll
                for (int m = 0; m < 4; ++m) { const f32x2 st = SL[ai * HALF + wr * 64 + m * 16 + fr]; acc[ai][bj][m][n] = (acc[ai][bj][m][n] - a1 * st[0]) * st[1] + a2; } }
}

struct EpiSwiGLU {
    static constexpr bool PERM = true;
    bf16_t* O; const float* ST; const float* c1; const float* c2;
    __device__ __forceinline__ void operator()(Acc& acc, const Unit& u, int wr, int wc, int fr, int fq, LAS unsigned char* lds) const {
        if (ST) { row_stats_table(lds, ST, u.pm); ln_fold_fix<true>(acc, u, wr, wc, fr, fq, c1, c2, lds); }
        const int row0 = u.pm * BM + wr * 64 + fr, col0 = u.pn * 128 + wc * 32 + 8 * fq;
#pragma unroll
        for (int ai = 0; ai < 2; ++ai)
#pragma unroll
            for (int m = 0; m < 4; ++m) {
                const f32x4 g0 = acc[ai][0][m][0], g1 = acc[ai][0][m][1], u0 = acc[ai][1][m][0], u1 = acc[ai][1][m][1];
                u32x4 w;
                w.x = pk2(silu_f(g0[0]) * u0[0], silu_f(g0[1]) * u0[1]); w.y = pk2(silu_f(g0[2]) * u0[2], silu_f(g0[3]) * u0[3]);
                w.z = pk2(silu_f(g1[0]) * u1[0], silu_f(g1[1]) * u1[1]); w.w = pk2(silu_f(g1[2]) * u1[2], silu_f(g1[3]) * u1[3]);
                *(GASP u32x4*)(O + (size_t)(row0 + ai * HALF + m * 16) * FF + col0) = w;
            }
    }
};
struct EpiResid {
    static constexpr bool PERM = false;
    const float* res0; const float* res1; int split; float* out; float scale;
    const float* STp; const float* gam; const float* bet; bf16_t* ob; float* STn;
    const bf16_t* resb;
    __device__ __forceinline__ void operator()(Acc& acc, const Unit& u, int wr, int wc, int fr, int fq, LAS unsigned char* lds) const {
        const int col0 = u.pn * BM + wc * 32 + 4 * fq;
        if (STp) row_stats_table(lds, STp, u.pm);
        const LAS f32x2* SL = (const LAS f32x2*)(lds + SL_OFF);
        f32x4 gg[2][2], bb[2][2];
        if (STp) {
#pragma unroll
            for (int bj = 0; bj < 2; ++bj)
#pragma unroll
                for (int n = 0; n < 2; ++n) { gg[bj][n] = *(const GASP f32x4*)(gam + col0 + bj * HALF + n * 16); bb[bj][n] = *(const GASP f32x4*)(bet + col0 + bj * HALF + n * 16); }
        }
#pragma unroll
        for (int ai = 0; ai < 2; ++ai)
#pragma unroll
            for (int m = 0; m < 4; ++m) {
                const int rl = ai * HALF + wr * 64 + m * 16 + fr, row = u.pm * BM + rl;
                const float* rp = (row < split) ? res0 + (size_t)row * D : res1 + (size_t)(row - split) * D;
                float* op = out + (size_t)row * D;
                f32x2 st = (f32x2){0.f, 1.f}; if (STp) st = SL[rl];
                float s = 0.f, q = 0.f;
#pragma unroll
                for (int bj = 0; bj < 2; ++bj)
#pragma unroll
                    for (int n = 0; n < 2; ++n) { const int c = col0 + bj * HALF + n * 16; f32x4 r;
                        if (resb) { const u32x2 w = *(const GASP u32x2*)(resb + (size_t)row * D + c);
                            r = (f32x4){__uint_as_float(w.x << 16), __uint_as_float(w.x & 0xffff0000u), __uint_as_float(w.y << 16), __uint_as_float(w.y & 0xffff0000u)}; }
                        else r = *(const GASP f32x4*)(rp + c);
                        if (STp) r = (r - st[0]) * st[1] * gg[bj][n] + bb[bj][n];
                        const f32x4 o = r * ALPHA + acc[ai][bj][m][n] * scale;
                        if (out) *(GASP f32x4*)(op + c) = o;
                        if (ob) { u32x2 w; w.x = pk2(o[0], o[1]); w.y = pk2(o[2], o[3]); *(GASP u32x2*)(ob + (size_t)row * D + c) = w; }
                        s += (o[0] + o[1]) + (o[2] + o[3]); q += (o[0] * o[0] + o[1] * o[1]) + (o[2] * o[2] + o[3] * o[3]); }
                if (STn) { s += __shfl_xor(s, 16); s += __shfl_xor(s, 32); q += __shfl_xor(q, 16); q += __shfl_xor(q, 32);
                    if (fq == 0) *(GASP f32x2*)(STn + (size_t)row * 32 + (u.pn * 4 + wc) * 2) = (f32x2){s, q}; }
            }
    }
};
struct EpiBf16 {
    static constexpr bool PERM = true;
    bf16_t* O; int ldc; float scale; const float* ST; const float* c1; const float* c2;
    __device__ __forceinline__ void operator()(Acc& acc, const Unit& u, int wr, int wc, int fr, int fq, LAS unsigned char* lds) const {
        if (ST) { row_stats_table(lds, ST, u.pm); ln_fold_fix<true>(acc, u, wr, wc, fr, fq, c1, c2, lds); }
        const int row0 = u.pm * BM + wr * 64 + fr, col0 = u.pn * BM + wc * 32 + 8 * fq;
#pragma unroll
        for (int ai = 0; ai < 2; ++ai)
#pragma unroll
            for (int m = 0; m < 4; ++m)
#pragma unroll
                for (int bj = 0; bj < 2; ++bj) { const f32x4 v0 = acc[ai][bj][m][0] * scale, v1 = acc[ai][bj][m][1] * scale;
                    u32x4 w; w.x = pk2(v0[0], v0[1]); w.y = pk2(v0[2], v0[3]); w.z = pk2(v1[0], v1[1]); w.w = pk2(v1[2], v1[3]);
                    *(GASP u32x4*)(O + (size_t)(row0 + ai * HALF + m * 16) * ldc + col0 + bj * HALF) = w; }
    }
};
struct EpiMem {
    static constexpr bool PERM = true;
    float* outk; float* outv; bf16_t* kb; bf16_t* vb;
    __device__ __forceinline__ void operator()(Acc& acc, const Unit& u, int wr, int wc, int fr, int fq, LAS unsigned char*) const {
        const int row0 = u.pm * BM + wr * 64 + fr; int colt = u.pn * BM; const bool isv = colt >= D; if (isv) colt -= D;
        float* of = isv ? outv : outk; bf16_t* ob = isv ? vb : kb;
        const int col0 = colt + wc * 32 + 8 * fq;
#pragma unroll
        for (int ai = 0; ai < 2; ++ai)
#pragma unroll
            for (int m = 0; m < 4; ++m)
#pragma unroll
                for (int bj = 0; bj < 2; ++bj) { const f32x4 v0 = acc[ai][bj][m][0], v1 = acc[ai][bj][m][1];
                    const size_t o = (size_t)(row0 + ai * HALF + m * 16) * D + col0 + bj * HALF;
                    *(GASP f32x4*)(of + o) = v0; *(GASP f32x4*)(of + o + 4) = v1;
                    u32x4 w; w.x = pk2(v0[0], v0[1]); w.y = pk2(v0[2], v0[3]); w.z = pk2(v1[0], v1[1]); w.w = pk2(v1[2], v1[3]);
                    *(GASP u32x4*)(ob + o) = w; }
    }
};
struct EpiIn {
    static constexpr bool PERM = true;
    bf16_t *qb, *kb, *vb, *ub; float* gvf; float* out; float qscale; const float* ST; const float* c1; const float* c2; float* gst;
    __device__ __forceinline__ void operator()(Acc& acc, const Unit& u, int wr, int wc, int fr, int fq, LAS unsigned char* lds) const {
        row_stats_table(lds, ST, u.pm); ln_fold_fix<true>(acc, u, wr, wc, fr, fq, c1, c2, lds);
        const int row0 = u.pm * BM + wr * 64 + fr; const int sec = u.pn >> 1; const int col0 = (u.pn & 1) * BM + wc * 32 + 8 * fq;
#pragma unroll
        for (int ai = 0; ai < 2; ++ai)
#pragma unroll
            for (int m = 0; m < 4; ++m) {
                const int row = row0 + ai * HALF + m * 16;
                float gs = 0.f, gq = 0.f;
#pragma unroll
                for (int bj = 0; bj < 2; ++bj) {
                    f32x4 v0 = acc[ai][bj][m][0], v1 = acc[ai][bj][m][1];
                    const size_t o = (size_t)row * 512 + col0 + bj * HALF;
                    if (sec == 0) { v0 = v0 * qscale; v1 = v1 * qscale; }
                    if (sec == 1) { float* of = (row < NP ? out + OUT_KP + (size_t)row * 512 : out + OUT_KS + (size_t)(row - NP) * 512) + col0 + bj * HALF; *(GASP f32x4*)of = v0; *(GASP f32x4*)(of + 4) = v1; }
                    if (sec == 2) { float* of = (row < NP ? out + OUT_VP + (size_t)row * 512 : out + OUT_VS + (size_t)(row - NP) * 512) + col0 + bj * HALF; *(GASP f32x4*)of = v0; *(GASP f32x4*)(of + 4) = v1; }
                    if (sec >= 3) {
#pragma unroll
                        for (int j = 0; j < 4; ++j) { v0[j] = gelu_f(v0[j]); v1[j] = gelu_f(v1[j]); }
                    }
                    if (sec == 4) { *(GASP f32x4*)(gvf + o) = v0; *(GASP f32x4*)(gvf + o + 4) = v1;
                        gs += ((v0[0] + v0[1]) + (v0[2] + v0[3])) + ((v1[0] + v1[1]) + (v1[2] + v1[3]));
                        gq += ((v0[0] * v0[0] + v0[1] * v0[1]) + (v0[2] * v0[2] + v0[3] * v0[3])) + ((v1[0] * v1[0] + v1[1] * v1[1]) + (v1[2] * v1[2] + v1[3] * v1[3])); }
                    else {
                        u32x4 w; w.x = pk2(v0[0], v0[1]); w.y = pk2(v0[2], v0[3]); w.z = pk2(v1[0], v1[1]); w.w = pk2(v1[2], v1[3]);
                        if (sec == 0) *(GASP u32x4*)(qb + o) = w; else if (sec == 1) *(GASP u32x4*)(kb + o) = w; else if (sec == 2) *(GASP u32x4*)(vb + o) = w; else *(GASP u32x4*)(ub + o) = w;
                    }
                }
                if (sec == 4) { gs += __shfl_xor(gs, 16); gs += __shfl_xor(gs, 32); gq += __shfl_xor(gq, 16); gq += __shfl_xor(gq, 32);
                    if (fq == 0) *(GASP f32x2*)(gst + (size_t)row * 16 + ((u.pn & 1) * 4 + wc) * 2) = (f32x2){gs, gq}; }
            }
    }
};

struct SplitKOrder {
    int S, Ks, G, c;
    __host__ __device__ bool next(int i, Unit& u) const {
        const int L = i * G + c; if (L >= 16 * S) return false;
        const int tile = L / S, ks = L - tile * S; u.pm = NP / BM + (tile >> 2); u.pn = tile & 3; u.kofs = ks * Ks; return true;
    }
};
struct EpiPartial {
    static constexpr bool PERM = false;
    float* slab; int Ks;
    __device__ __forceinline__ void operator()(Acc& acc, const Unit& u, int wr, int wc, int fr, int fq, LAS unsigned char*) const {
        float* base = slab + (size_t)(u.kofs / Ks) * NS * D; const int col0 = u.pn * BM + wc * 32 + 4 * fq;
#pragma unroll
        for (int ai = 0; ai < 2; ++ai)
#pragma unroll
            for (int m = 0; m < 4; ++m) { float* op = base + (size_t)(u.pm * BM - NP + ai * HALF + wr * 64 + m * 16 + fr) * D + col0;
#pragma unroll
                for (int bj = 0; bj < 2; ++bj)
#pragma unroll
                    for (int n = 0; n < 2; ++n) *(GASP f32x4*)(op + bj * HALF + n * 16) = acc[ai][bj][m][n]; }
    }
};
}

__device__ __forceinline__ void transpose_item(const float* W, int K, int N, bf16_t* WT, int item, int gu, LAS float* tile,
                                               const float* gam = nullptr, const float* bet = nullptr, float* c1p = nullptr, float* c2p = nullptr) {
    const int tid = threadIdx.x, nblk = N / 64, kb = item / nblk, nb = item % nblk, k0 = kb * 64, n0 = nb * 64;
    { const int r = tid >> 3, c8 = (tid & 7) * 8; const float* src = W + (size_t)(k0 + r) * N + n0 + c8;
      const f32x4 a = *(const GASP f32x4*)src, b = *(const GASP f32x4*)(src + 4);
      LAS float* t = tile + r * 65 + c8; t[0] = a[0]; t[1] = a[1]; t[2] = a[2]; t[3] = a[3]; t[4] = b[0]; t[5] = b[1]; t[6] = b[2]; t[7] = b[3]; }
    __syncthreads();
    { const int n = tid >> 3, k8 = (tid & 7) * 8; const LAS float* t = tile + k8 * 65 + n;
      float w[8];
#pragma unroll
      for (int i = 0; i < 8; ++i) w[i] = t[i * 65];
      int nn = n0 + n; if (gu) nn = (nn < FF) ? ((nn >> 7) * 256 + (nn & 127)) : (((nn - FF) >> 7) * 256 + 128 + ((nn - FF) & 127));
      float s2 = 0.f;
      if (gam) {
#pragma unroll
          for (int i = 0; i < 8; ++i) { s2 += bet[k0 + k8 + i] * w[i]; w[i] *= gam[k0 + k8 + i]; }
      }
      u32x4 o; o.x = pk2(w[0], w[1]); o.y = pk2(w[2], w[3]); o.z = pk2(w[4], w[5]); o.w = pk2(w[6], w[7]);
      *(GASP u32x4*)(WT + (size_t)nn * K + k0 + k8) = o;
      if (gam) {
          float s1 = ((__uint_as_float(o.x << 16) + __uint_as_float(o.x & 0xffff0000u)) + (__uint_as_float(o.y << 16) + __uint_as_float(o.y & 0xffff0000u)))
                   + ((__uint_as_float(o.z << 16) + __uint_as_float(o.z & 0xffff0000u)) + (__uint_as_float(o.w << 16) + __uint_as_float(o.w & 0xffff0000u)));
          s1 += __shfl_xor(s1, 1); s1 += __shfl_xor(s1, 2); s1 += __shfl_xor(s1, 4);
          s2 += __shfl_xor(s2, 1); s2 += __shfl_xor(s2, 2); s2 += __shfl_xor(s2, 4);
          if ((tid & 7) == 0) { c1p[(size_t)kb * NC12 + nn] = s1; c2p[(size_t)kb * NC12 + nn] = s2; }
      } }
    __syncthreads();
}
__device__ __forceinline__ void cvt_rows(const float* src, bf16_t* dst, size_t n8, size_t gtid, size_t gn) {
    for (size_t i = gtid; i < n8; i += gn) { const f32x4 a = *(const GASP f32x4*)(src + 8 * i), b = *(const GASP f32x4*)(src + 8 * i + 4);
        u32x4 o; o.x = pk2(a[0], a[1]); o.y = pk2(a[2], a[3]); o.z = pk2(b[0], b[1]); o.w = pk2(b[2], b[3]); *(GASP u32x4*)(dst + 8 * i) = o; }
}
__device__ __forceinline__ void phase_prep(const Params& p, LAS unsigned char* lds) {
    unsigned char* ws = p.ws; const int G = gridDim.x, bx = blockIdx.x;
    if (bx == 0 && threadIdx.x < 64) ((unsigned*)(ws + O_CTR))[threadIdx.x] = 0u;
    LAS float* tile = (LAS float*)lds;
    constexpr int I_GU = 16 * 88, I_DN = 44 * 16, I_IN = 16 * 40, I_SQ = 16 * 16;
    constexpr int NIT = 2 * I_GU + 2 * I_DN + I_IN + 5 * I_SQ;
    const size_t gtid = (size_t)bx * 512 + threadIdx.x, gn = (size_t)G * 512;
#define PREP_CVT() do { \
        cvt_rows(p.in[0], (bf16_t*)(ws + O_XB), (size_t)NP * D / 8, gtid, gn); \
        cvt_rows(p.in[1], (bf16_t*)(ws + O_XB) + (size_t)NP * D, (size_t)NS * D / 8, gtid, gn); \
        cvt_rows(p.in[6], (bf16_t*)(ws + O_MEMB), (size_t)4096 * D / 8, gtid, gn); \
    } while (0)
    if (bx & 1) PREP_CVT();
    for (int it = bx; it < NIT; it += G) {
        int r = it;
        if (r < I_GU) { transpose_item(p.in[7], D, 2 * FF, (bf16_t*)(ws + O_WGU1), r, 1, tile); continue; } r -= I_GU;
        if (r < I_GU) { transpose_item(p.in[30], D, 2 * FF, (bf16_t*)(ws + O_WGU2), r, 1, tile, p.in[28], p.in[29], (float*)(ws + O_C1P) + C_GU2, (float*)(ws + O_C2P) + C_GU2); continue; } r -= I_GU;
        if (r < I_DN) { transpose_item(p.in[8], FF, D, (bf16_t*)(ws + O_WDN1), r, 0, tile); continue; } r -= I_DN;
        if (r < I_DN) { transpose_item(p.in[31], FF, D, (bf16_t*)(ws + O_WDN2), r, 0, tile); continue; } r -= I_DN;
        if (r < I_IN) { transpose_item(p.in[11], D, INC, (bf16_t*)(ws + O_WIN), r, 0, tile, p.in[9], p.in[10], (float*)(ws + O_C1P) + C_IN, (float*)(ws + O_C2P) + C_IN); continue; } r -= I_IN;
        if (r < I_SQ) { transpose_item(p.in[21], D, D, (bf16_t*)(ws + O_WOUT), r, 0, tile); continue; } r -= I_SQ;
        if (r < I_SQ) { transpose_item(p.in[24], D, D, (bf16_t*)(ws + O_WQ), r, 0, tile, p.in[22], p.in[23], (float*)(ws + O_C1P) + C_Q, (float*)(ws + O_C2P) + C_Q); continue; } r -= I_SQ;
        if (r < I_SQ) { transpose_item(p.in[25], D, D, (bf16_t*)(ws + O_WKV), r, 0, tile); continue; } r -= I_SQ;
        if (r < I_SQ) { transpose_item(p.in[26], D, D, (bf16_t*)(ws + O_WKV) + (size_t)D * D, r, 0, tile); continue; } r -= I_SQ;
        transpose_item(p.in[27], D, D, (bf16_t*)(ws + O_WO), r, 0, tile);
    }
    if (!(bx & 1)) PREP_CVT();
#undef PREP_CVT
    for (size_t i = gtid; i < 4 * 128 * 128 / 2; i += gn) { const int e = (int)i * 2, t = (e >> 7) & 127, s = e & 127;
        const float a = s <= t ? p.in[19][e] : 0.f, b = (s + 1) <= t ? p.in[19][e + 1] : 0.f; ((unsigned*)(ws + O_WSB))[i] = pk2(a, b); }
}

__device__ __forceinline__ void phase_ln(const bf16_t* src, float* dstf, bf16_t* dstb, const float* gam, const float* bet) {
    const int lane = threadIdx.x & 63, gw = blockIdx.x * 8 + (threadIdx.x >> 6), NGW = gridDim.x * 8;
    f32x4 gg[4], bb[4];
#pragma unroll
    for (int j = 0; j < 4; ++j) { gg[j] = ((const GASP f32x4*)gam)[64 * j + lane]; bb[j] = ((const GASP f32x4*)bet)[64 * j + lane]; }
    for (int row = gw; row < M; row += NGW) {
        const GASP u32x2* xr = (const GASP u32x2*)(src + (size_t)row * D) + lane;
        u32x2 raw[4];
#pragma unroll
        for (int j = 0; j < 4; ++j) raw[j] = xr[64 * j];
        f32x4 v[4]; float s = 0.f;
#pragma unroll
        for (int j = 0; j < 4; ++j) { v[j] = (f32x4){__uint_as_float(raw[j].x << 16), __uint_as_float(raw[j].x & 0xffff0000u), __uint_as_float(raw[j].y << 16), __uint_as_float(raw[j].y & 0xffff0000u)};
            s += (v[j][0] + v[j][1]) + (v[j][2] + v[j][3]); }
        const float mean = wave_sum(s) * (1.f / D); float s2 = 0.f;
#pragma unroll
        for (int j = 0; j < 4; ++j) { v[j] = v[j] - mean; s2 += (v[j][0] * v[j][0] + v[j][1] * v[j][1]) + (v[j][2] * v[j][2] + v[j][3] * v[j][3]); }
        const float rstd = 1.f / sqrtf(wave_sum(s2) * (1.f / D) + LN_EPS);
#pragma unroll
        for (int j = 0; j < 4; ++j) {
            const f32x4 y = v[j] * rstd * gg[j] + bb[j];
            ((GASP f32x4*)(dstf + (size_t)row * D))[64 * j + lane] = y;
            if (dstb) { u32x2 w; w.x = pk2(y[0], y[1]); w.y = pk2(y[2], y[3]); ((GASP u32x2*)(dstb + (size_t)row * D))[64 * j + lane] = w; }
        }
    }
}

__device__ __forceinline__ s16x4 vtr(const LAS unsigned char* p) { return __builtin_bit_cast(s16x4, __builtin_amdgcn_ds_read_tr16_b64_v4i16((LAS v4i16_t*)p)); }
__device__ __forceinline__ bf16x8 cat8(s16x4 lo, s16x4 hi) { return (bf16x8){lo[0], lo[1], lo[2], lo[3], hi[0], hi[1], hi[2], hi[3]}; }
__device__ __forceinline__ bf16x8 packp(const f32x16& x, int b) {
    u32x4 w; w.x = pk2(x[b], x[b + 1]); w.y = pk2(x[b + 2], x[b + 3]); w.z = pk2(x[b + 4], x[b + 5]); w.w = pk2(x[b + 6], x[b + 7]); return __builtin_bit_cast(bf16x8, w);
}
__device__ __forceinline__ u32x4 cvt8(u32x4 a, u32x4 b) {
    u32x4 o; o.x = pk2(__uint_as_float(a.x), __uint_as_float(a.y)); o.y = pk2(__uint_as_float(a.z), __uint_as_float(a.w));
    o.z = pk2(__uint_as_float(b.x), __uint_as_float(b.y)); o.w = pk2(__uint_as_float(b.z), __uint_as_float(b.w)); return o;
}
template <int NEB>
__device__ __forceinline__ void softmax_tile(f32x16& X0, f32x16& X1, float& m, float& l, f32x16 (&OT)[NEB]) {
    float mx = X0[0];
#pragma unroll
    for (int r = 1; r < 16; ++r) mx = fmaxf(mx, X0[r]);
#pragma unroll
    for (int r = 0; r < 16; ++r) mx = fmaxf(mx, X1[r]);
    mx = fmaxf(mx, __shfl_xor(mx, 32));
    if (__any(mx > m + 8.f)) {
        const float mn = fmaxf(m, mx), alpha = fexp2(m - mn); m = mn; l *= alpha;
#pragma unroll
        for (int e = 0; e < NEB; ++e) OT[e] = OT[e] * alpha;
    }
    float s = 0.f;
#pragma unroll
    for (int r = 0; r < 16; ++r) { X0[r] = fexp2(X0[r] - m); X1[r] = fexp2(X1[r] - m); s += X0[r] + X1[r]; }
    l += s;
}
template <int VRS, int NEB, bool SB = false>
__device__ __forceinline__ void pv_tile(f32x16 (&OT)[NEB], const f32x16& X0, const f32x16& X1, const LAS unsigned char* vlane  ) {
#pragma unroll
    for (int kk = 0; kk < 4; ++kk) {
        const bf16x8 pa = packp(kk < 2 ? X0 : X1, (kk & 1) * 8);
#pragma unroll
        for (int eb = 0; eb < NEB; ++eb) {
            const s16x4 lo = vtr(vlane + (kk * 16) * VRS + eb * 64), hi = vtr(vlane + (kk * 16 + 8) * VRS + eb * 64);
            OT[eb] = __builtin_amdgcn_mfma_f32_32x32x16_bf16(cat8(lo, hi), pa, OT[eb], 0, 0, 0);
        }
        if (SB) __builtin_amdgcn_sched_barrier(0);
    }
}

constexpr int DA_KRS = 144, DA_VRS = 320, DA_KMAP = 64 * DA_KRS, DA_VOFF = 2 * DA_KMAP, DA_BUF = DA_VOFF + 64 * DA_VRS;
template <bool SAMPLE, int EXPER = 0>
__device__ __forceinline__ void diff_unit(const Params& p, LAS unsigned char* L, int b, int h, int qi, float lam) {
    unsigned char* ws = p.ws;
    int tid = threadIdx.x; asm volatile("" : "+v"(tid));
    const int lane = tid & 63, r = lane & 31, hi = lane >> 5, wid = __builtin_amdgcn_readfirstlane(tid >> 6), map = wid >> 2, sub = wid & 3;
    const bf16_t* QB = (const bf16_t*)(ws + O_QB); const bf16_t* KB = (const bf16_t*)(ws + O_KB); const bf16_t* VB = (const bf16_t*)(ws + O_VB);
    constexpr int NEB = 4, NPF = SAMPLE ? 8 : 4;
    const int S = SAMPLE ? PAST + DECS : SEQ, qpos0 = SAMPLE ? PAST : qi * 128 + sub * 32, rowq0 = SAMPLE ? NP + b * 32 : b * SEQ + qi * 128 + sub * 32;
    const int NT = SAMPLE ? (PAST + DECS + 63) / 64 : 2 * qi + 2;
    const int ntw = SAMPLE ? NT : min(NT, (qpos0 >> 6) + 1);
    const float slope2 = exp2f(-2.f * (float)(h + 1)) * LOG2E;
    bf16x8 qf[4];
    { const bf16_t* qp = QB + (size_t)(rowq0 + r) * 512 + h * 128 + map * 64 + hi * 8;
#pragma unroll
      for (int d0 = 0; d0 < 4; ++d0) qf[d0] = *(const GASP bf16x8*)(qp + d0 * 16); }
    f32x16 OT[NEB];
#pragma unroll
    for (int e = 0; e < NEB; ++e)
#pragma unroll
        for (int i = 0; i < 16; ++i) OT[e][i] = 0.f;
    float m = -1e30f, l = 0.f;
    const int lkey = tid >> 3, lc = tid & 7;
    u32x4 pfA[NPF], pfB[SAMPLE ? 1 : NPF];
    const float* ck = p.in[2]; const float* cv = p.in[3];
#define DA_ISSUE(pf, tt) do { const int s_ = (tt) * 64 + lkey; \
        if (SAMPLE && (tt) < PAST / 64) { const size_t o_ = ((size_t)(b * PAST + s_) * 512 + h * 128 + lc * 16); \
            _Pragma("unroll") for (int i_ = 0; i_ < 4; ++i_) { pf[i_] = *(const GASP u32x4*)(ck + o_ + 4 * i_); pf[NPF - 4 + i_] = *(const GASP u32x4*)(cv + o_ + 4 * i_); } } \
        else { const int row_ = SAMPLE ? NP + b * 32 + min(s_ - PAST, DECS - 1) : b * SEQ + s_; const size_t o_ = (size_t)row_ * 512 + h * 128 + lc * 16; \
            pf[0] = *(const GASP u32x4*)(KB + o_); pf[1] = *(const GASP u32x4*)(KB + o_ + 8); pf[2] = *(const GASP u32x4*)(VB + o_); pf[3] = *(const GASP u32x4*)(VB + o_ + 8); } } while (0)
#define DA_WRITE(pf, tt, buf) do { u32x4 k0_, k1_, v0_, v1_; \
        if (SAMPLE && (tt) < PAST / 64) { k0_ = cvt8(pf[0], pf[1]); k1_ = cvt8(pf[2], pf[3]); v0_ = cvt8(pf[NPF - 4], pf[NPF - 3]); v1_ = cvt8(pf[NPF - 2], pf[NPF - 1]); } \
        else { k0_ = pf[0]; k1_ = pf[1]; v0_ = pf[2]; v1_ = pf[3]; } \
        LAS unsigned char* kd_ = L + (buf) * DA_BUF + (lc >> 2) * DA_KMAP + lkey * DA_KRS + (lc & 3) * 32; \
        LAS unsigned char* vd_ = L + (buf) * DA_BUF + DA_VOFF + lkey * DA_VRS + lc * 32; \
        *(LAS u32x4*)kd_ = k0_; *(LAS u32x4*)(kd_ + 16) = k1_; *(LAS u32x4*)vd_ = v0_; *(LAS u32x4*)(vd_ + 16) = v1_; } while (0)
    const int i16 = lane & 15;
    const int vlane_off = (4 * hi + (i16 >> 2)) * DA_VRS + (16 * ((lane >> 4) & 1) + 4 * (i16 & 3)) * 2;
    const int tq = qpos0 + r;
#define DA_COMPUTE(tt, buf) do { if ((tt) < ntw && (!SAMPLE || (((tt) & 3) == sub))) { \
            const LAS unsigned char* Kb = L + (buf) * DA_BUF + map * DA_KMAP + r * DA_KRS + hi * 16; \
            f32x16 X0, X1; \
            _Pragma("unroll") for (int i = 0; i < 16; ++i) { X0[i] = 0.f; X1[i] = 0.f; } \
            _Pragma("unroll") for (int d0 = 0; d0 < 4; ++d0) { \
                const bf16x8 k0 = *(const LAS bf16x8*)(Kb + d0 * 32), k1 = *(const LAS bf16x8*)(Kb + 32 * DA_KRS + d0 * 32); \
                X0 = __builtin_amdgcn_mfma_f32_32x32x16_bf16(k0, qf[d0], X0, 0, 0, 0); \
                X1 = __builtin_amdgcn_mfma_f32_32x32x16_bf16(k1, qf[d0], X1, 0, 0, 0); } \
            const float dd0 = (float)(tq - ((tt) * 64 + 4 * hi)); \
            _Pragma("unroll") for (int rg = 0; rg < 16; ++rg) { const float c = (float)((rg & 3) + 8 * (rg >> 2)); \
                X0[rg] = X0[rg] - slope2 * fabsf(dd0 - c); X1[rg] = X1[rg] - slope2 * fabsf(dd0 - 32.f - c); } \
            if ((tt) * 64 + 32 >= S) { _Pragma("unroll") for (int rg = 0; rg < 16; ++rg) X1[rg] = -1e30f; } \
            if (!(EXPER & 2)) softmax_tile<NEB>(X0, X1, m, l, OT); else l += X0[0]; \
            if (!(EXPER & 1)) pv_tile<DA_VRS, NEB, SAMPLE>(OT, X0, X1, L + (buf) * DA_BUF + DA_VOFF + vlane_off); else OT[0] = OT[0] + X0 + X1; } } while (0)
    DA_ISSUE(pfA, 0); DA_WRITE(pfA, 0, 0);
    if constexpr (SAMPLE) {
        asm volatile("" : "+v"(qf[0]), "+v"(qf[1]), "+v"(qf[2]), "+v"(qf[3]));
        __syncthreads();
#pragma unroll 1
        for (int tt = 0; tt < NT; ++tt) {
            if (tt + 1 < NT) DA_ISSUE(pfA, tt + 1);
            DA_COMPUTE(tt, tt & 1);
            if (tt + 1 < NT) DA_WRITE(pfA, tt + 1, (tt + 1) & 1);
            __syncthreads();
        }
    } else {
    if (NT > 1) DA_ISSUE(pfA, 1);
    asm volatile("" : "+v"(qf[0]), "+v"(qf[1]), "+v"(qf[2]), "+v"(qf[3]));
    __syncthreads();
    for (int tt = 0; tt < NT; tt += 2) {
        if (tt + 2 < NT) DA_ISSUE(pfB, tt + 2);
        DA_COMPUTE(tt, 0);
        if (tt + 1 < NT) DA_WRITE(pfA, tt + 1, 1);
        __syncthreads();
        if (tt + 1 >= NT) break;
        if (tt + 3 < NT) DA_ISSUE(pfA, tt + 3);
        DA_COMPUTE(tt + 1, 1);
        if (tt + 2 < NT) DA_WRITE(pfB, tt + 2, 0);
        __syncthreads();
    }
    }
#undef DA_COMPUTE
#undef DA_ISSUE
#undef DA_WRITE
    l += __shfl_xor(l, 32);
    if constexpr (SAMPLE) {
        LAS float* SLB = (LAS float*)L; LAS f32x2* ML = (LAS f32x2*)(L + 131072); LAS float* SS = (LAS float*)(L + 131072 + 2048);
        if (hi == 0) ML[(map * 4 + sub) * 32 + r] = (f32x2){m, l};
        __syncthreads();
        float M = -1e30f;
#pragma unroll
        for (int s4 = 0; s4 < 4; ++s4) M = fmaxf(M, ML[(map * 4 + s4) * 32 + r][0]);
        float Lsum = 0.f;
#pragma unroll
        for (int s4 = 0; s4 < 4; ++s4) { const f32x2 v = ML[(map * 4 + s4) * 32 + r]; Lsum += v[1] * fexp2(v[0] - M); }
        const float f = fexp2(m - M) * frcp(Lsum);
        LAS float* mine = SLB + (map * 4 + sub) * 4096;
#pragma unroll
        for (int eb = 0; eb < 4; ++eb)
#pragma unroll
            for (int rg = 0; rg < 16; ++rg) mine[(eb * 32 + (rg & 3) + 8 * (rg >> 2) + 4 * hi) * 32 + r] = OT[eb][rg] * f;
        __syncthreads();
        float o16[16]; float ss = 0.f;
        if (map == 0) {
#pragma unroll
            for (int rg = 0; rg < 16; ++rg) { const int idx = (sub * 32 + (rg & 3) + 8 * (rg >> 2) + 4 * hi) * 32 + r;
                const float o1 = (SLB[idx] + SLB[4096 + idx]) + (SLB[2 * 4096 + idx] + SLB[3 * 4096 + idx]);
                const float o2 = (SLB[4 * 4096 + idx] + SLB[5 * 4096 + idx]) + (SLB[6 * 4096 + idx] + SLB[7 * 4096 + idx]);
                const float o = o1 - lam * o2; o16[rg] = o; ss += o * o; }
            ss += __shfl_xor(ss, 32);
            if (hi == 0) SS[sub * 32 + r] = ss;
        }
        __syncthreads();
        if (map == 0) {
            ss = (SS[r] + SS[32 + r]) + (SS[64 + r] + SS[96 + r]);
            const float rms = 0.8f / sqrtf(ss * (1.f / 128.f) + LN_EPS);
            const float* sg = p.in[16];
            bf16_t* op = (bf16_t*)(ws + O_MIX) + (size_t)(rowq0 + r) * D + h * 128 + sub * 32 + 4 * hi;
#pragma unroll
            for (int g4 = 0; g4 < 4; ++g4) { const f32x4 gv = *(const GASP f32x4*)(sg + sub * 32 + 8 * g4 + 4 * hi);
                u32x2 w; w.x = pk2(o16[4 * g4] * rms * gv[0], o16[4 * g4 + 1] * rms * gv[1]); w.y = pk2(o16[4 * g4 + 2] * rms * gv[2], o16[4 * g4 + 3] * rms * gv[3]);
                *(GASP u32x2*)(op + 8 * g4) = w; }
        }
        __syncthreads();
    } else {
        const float inv = frcp(l);
        LAS float* X = (LAS float*)L + sub * 4096;
        if (map == 1) {
#pragma unroll
            for (int eb = 0; eb < 4; ++eb)
#pragma unroll
                for (int rg = 0; rg < 16; ++rg) X[(eb * 32 + (rg & 3) + 8 * (rg >> 2) + 4 * hi) * 32 + r] = OT[eb][rg] * inv;
        }
        __syncthreads();
        if (map == 0) {
            float ss = 0.f;
#pragma unroll
            for (int eb = 0; eb < 4; ++eb)
#pragma unroll
                for (int rg = 0; rg < 16; ++rg) { const float o = OT[eb][rg] * inv - lam * X[(eb * 32 + (rg & 3) + 8 * (rg >> 2) + 4 * hi) * 32 + r]; OT[eb][rg] = o; ss += o * o; }
            ss += __shfl_xor(ss, 32);
            const float rms = 0.8f / sqrtf(ss * (1.f / 128.f) + LN_EPS);
            const float* sg = p.in[16];
            bf16_t* op = (bf16_t*)(ws + O_MIX) + (size_t)(rowq0 + r) * D + h * 128 + 4 * hi;
#pragma unroll
            for (int eb = 0; eb < 4; ++eb)
#pragma unroll
                for (int g4 = 0; g4 < 4; ++g4) { const int e0 = eb * 32 + 8 * g4; const f32x4 gv = *(const GASP f32x4*)(sg + e0 + 4 * hi);
                    u32x2 w; w.x = pk2(OT[eb][4 * g4] * rms * gv[0], OT[eb][4 * g4 + 1] * rms * gv[1]); w.y = pk2(OT[eb][4 * g4 + 2] * rms * gv[2], OT[eb][4 * g4 + 3] * rms * gv[3]);
                    *(GASP u32x2*)(op + e0) = w; }
        }
        __syncthreads();
    }
}

__device__ __forceinline__ void gate_unit(const Params& p, LAS unsigned char* L, int row0, int n, int g, int sample_b) {
    unsigned char* ws = p.ws;
    int tid = threadIdx.x; asm volatile("" : "+v"(tid));
    const int lane = tid & 63, r = lane & 31, hi = lane >> 5, wid = __builtin_amdgcn_readfirstlane(tid >> 6);
    const float* GVF = (const float*)(ws + O_GVF); const float* GST = (const float*)(ws + O_GST); const bf16_t* UB = (const bf16_t*)(ws + O_UB); const bf16_t* WSB = (const bf16_t*)(ws + O_WSB);
    const float* lng = p.in[17]; const float* lnb = p.in[18]; const float* bs = p.in[20];
    const int tb = wid & 3, dh = wid >> 2;
    const bool active = tb * 32 < n;
    const int nks = active ? min((tb + 1) * 2, n / 16) : 0;
    const int t = tid >> 2, ch = tid & 3; const bool ldr = t < n;
    f32x4 xv[8], sp[4];
    if (ldr) { const float* src = GVF + (size_t)(row0 + t) * 512 + g * 128 + ch * 32; const GASP f32x4* sq = (const GASP f32x4*)(GST + (size_t)(row0 + t) * 16);
#pragma unroll
        for (int i = 0; i < 8; ++i) xv[i] = *(const GASP f32x4*)(src + 4 * i);
#pragma unroll
        for (int i = 0; i < 4; ++i) sp[i] = sq[i]; }
    bf16x8 wf[8];
    { const bf16_t* wp = WSB + (size_t)(g * 128 + tb * 32 + r) * 128 + 8 * hi;
#pragma unroll
      for (int ks = 0; ks < 8; ++ks) if (ks < nks) wf[ks] = *(const GASP bf16x8*)(wp + ks * 16); }
    const int te = tb * 32 + r;
    u32x2 uu[8]; float bias = 0.f;
    if (active) { const bf16_t* up = UB + (size_t)(row0 + te) * 512 + g * 128 + dh * 64 + 4 * hi; bias = bs[g * 128 + te];
#pragma unroll
        for (int i = 0; i < 8; ++i) uu[i] = *(const GASP u32x2*)(up + (i >> 2) * 32 + 8 * (i & 3)); }
    if (ldr) {
        float s = 0.f, q = 0.f;
#pragma unroll
        for (int i = 0; i < 4; ++i) { s += sp[i][0] + sp[i][2]; q += sp[i][1] + sp[i][3]; }
        const float mean = s * (1.f / 512.f), rstd = 1.f / sqrtf(q * (1.f / 512.f) - mean * mean + LN_EPS);
        const float* gp = lng + g * 128 + ch * 32; const float* bp = lnb + g * 128 + ch * 32;
#pragma unroll
        for (int i = 0; i < 4; ++i) {
            const f32x4 ya = (xv[2 * i] - mean) * rstd * *(const GASP f32x4*)(gp + 8 * i) + *(const GASP f32x4*)(bp + 8 * i);
            const f32x4 yc = (xv[2 * i + 1] - mean) * rstd * *(const GASP f32x4*)(gp + 8 * i + 4) + *(const GASP f32x4*)(bp + 8 * i + 4);
            u32x4 w; w.x = pk2(ya[0], ya[1]); w.y = pk2(ya[2], ya[3]); w.z = pk2(yc[0], yc[1]); w.w = pk2(yc[2], yc[3]);
            *(LAS u32x4*)(L + t * DA_VRS + ch * 64 + i * 16) = w;
            if (sample_b >= 0) { float* o = p.out + OUT_GV + (size_t)(sample_b * 32 + t) * 512 + g * 128 + ch * 32 + 8 * i; *(GASP f32x4*)o = ya; *(GASP f32x4*)(o + 4) = yc; }
        }
    }
    __syncthreads();
    if (active) {
        const int i16 = lane & 15;
        const int vlane_off = (8 * hi + (i16 >> 2)) * DA_VRS + (16 * ((lane >> 4) & 1) + 4 * (i16 & 3)) * 2 + dh * 128;
        f32x16 OT[2];
#pragma unroll
        for (int e = 0; e < 2; ++e)
#pragma unroll
            for (int i = 0; i < 16; ++i) OT[e][i] = 0.f;
#pragma unroll
        for (int ks = 0; ks < 8; ++ks) if (ks < nks) {
#pragma unroll
            for (int db = 0; db < 2; ++db) {
                const s16x4 lo = vtr(L + vlane_off + (ks * 16) * DA_VRS + db * 64), hi4 = vtr(L + vlane_off + (ks * 16 + 4) * DA_VRS + db * 64);
                OT[db] = __builtin_amdgcn_mfma_f32_32x32x16_bf16(cat8(lo, hi4), wf[ks], OT[db], 0, 0, 0);
            }
        }
        bf16_t* op = (bf16_t*)(ws + O_MIX) + (size_t)(row0 + te) * D + 512 + g * 128 + dh * 64 + 4 * hi;
#pragma unroll
        for (int db = 0; db < 2; ++db)
#pragma unroll
            for (int g4 = 0; g4 < 4; ++g4) { const u32x2 u2 = uu[db * 4 + g4];
                const float u0 = __uint_as_float(u2.x << 16), u1 = __uint_as_float(u2.x & 0xffff0000u), u2f = __uint_as_float(u2.y << 16), u3 = __uint_as_float(u2.y & 0xffff0000u);
                u32x2 w; w.x = pk2(u0 * (OT[db][4 * g4] + bias), u1 * (OT[db][4 * g4 + 1] + bias)); w.y = pk2(u2f * (OT[db][4 * g4 + 2] + bias), u3 * (OT[db][4 * g4 + 3] + bias));
                *(GASP u32x2*)(op + db * 32 + 8 * g4) = w; }
    }
    __syncthreads();
}

constexpr int CA_KRS = 528, CA_VRS = 576, CA_VOFF = 64 * CA_KRS, CA_BUF = CA_VOFF + 64 * CA_VRS;
__device__ __forceinline__ void cross_unit(const Params& p, LAS unsigned char* L, int bb, int h, int qi) {
    unsigned char* ws = p.ws;
    int tid = threadIdx.x; asm volatile("" : "+v"(tid));
    const int lane = tid & 63, r = lane & 31, hi = lane >> 5, wid = __builtin_amdgcn_readfirstlane(tid >> 6), sub = wid & 3, dh = wid >> 2;
    const bf16_t* QC = (const bf16_t*)(ws + O_QC); const bf16_t* MKB = (const bf16_t*)(ws + O_MKB); const bf16_t* MVB = (const bf16_t*)(ws + O_MVB);
    const int nq = bb < 16 ? 128 : 32, rowq0 = bb < 16 ? bb * SEQ + qi * 128 : NP + (bb - 16) * 32;
    const bool active = sub * 32 < nq;
    const bf16_t* qp = QC + (size_t)(rowq0 + (active ? sub * 32 : 0) + r) * D + h * 256 + hi * 8;
    bf16x8 qf[16];
#pragma unroll
    for (int d0 = 0; d0 < 16; ++d0) qf[d0] = *(const GASP bf16x8*)(qp + d0 * 16);
    f32x16 OT[4];
#pragma unroll
    for (int e = 0; e < 4; ++e)
#pragma unroll
        for (int i = 0; i < 16; ++i) OT[e][i] = 0.f;
    float m = -1e30f, l = 0.f;
    const int lrow = tid >> 3, lc = tid & 7;
    u32x4 pf[8];
#define CA_ISSUE(tt) do { const size_t o_ = (size_t)(bb * 256 + (tt) * 64 + lrow) * D + h * 256 + lc * 32; \
        _Pragma("unroll") for (int i_ = 0; i_ < 4; ++i_) { pf[i_] = *(const GASP u32x4*)(MKB + o_ + 8 * i_); pf[4 + i_] = *(const GASP u32x4*)(MVB + o_ + 8 * i_); } } while (0)
#define CA_WRITE(buf) do { LAS unsigned char* kd_ = L + (buf) * CA_BUF + lrow * CA_KRS + lc * 64; LAS unsigned char* vd_ = L + (buf) * CA_BUF + CA_VOFF + lrow * CA_VRS + lc * 64; \
        _Pragma("unroll") for (int i_ = 0; i_ < 4; ++i_) { *(LAS u32x4*)(kd_ + 16 * i_) = pf[i_]; *(LAS u32x4*)(vd_ + 16 * i_) = pf[4 + i_]; } } while (0)
    CA_ISSUE(0); CA_WRITE(0);
#pragma unroll
    for (int d0 = 0; d0 < 16; ++d0) asm volatile("" : "+v"(qf[d0]));
    __syncthreads();
    const int i16 = lane & 15;
    const int vlane_off = (4 * hi + (i16 >> 2)) * CA_VRS + (16 * ((lane >> 4) & 1) + 4 * (i16 & 3)) * 2 + dh * 256;
#pragma unroll 1
    for (int tt = 0; tt < 4; ++tt) {
        const int buf = tt & 1;
        if (tt + 1 < 4) CA_ISSUE(tt + 1);
        if (active) {
            const LAS unsigned char* Kb = L + buf * CA_BUF + r * CA_KRS + hi * 16;
            f32x16 X0, X1;
#pragma unroll
            for (int i = 0; i < 16; ++i) { X0[i] = 0.f; X1[i] = 0.f; }
#pragma unroll
            for (int d0 = 0; d0 < 16; ++d0) {
                const bf16x8 k0 = *(const LAS bf16x8*)(Kb + d0 * 32), k1 = *(const LAS bf16x8*)(Kb + 32 * CA_KRS + d0 * 32);
                X0 = __builtin_amdgcn_mfma_f32_32x32x16_bf16(k0, qf[d0], X0, 0, 0, 0);
                X1 = __builtin_amdgcn_mfma_f32_32x32x16_bf16(k1, qf[d0], X1, 0, 0, 0);
            }
            softmax_tile<4>(X0, X1, m, l, OT);
            pv_tile<CA_VRS, 4>(OT, X0, X1, L + buf * CA_BUF + CA_VOFF + vlane_off);
        }
        if (tt + 1 < 4) CA_WRITE(buf ^ 1);
        __syncthreads();
    }
#undef CA_ISSUE
#undef CA_WRITE
    if (active) {
        l += __shfl_xor(l, 32);
        const float inv = frcp(l);
        bf16_t* op = (bf16_t*)(ws + O_OC) + (size_t)(rowq0 + sub * 32 + r) * D + h * 256 + dh * 128 + 4 * hi;
#pragma unroll
        for (int eb = 0; eb < 4; ++eb)
#pragma unroll
            for (int g4 = 0; g4 < 4; ++g4) { u32x2 w; w.x = pk2(OT[eb][4 * g4] * inv, OT[eb][4 * g4 + 1] * inv); w.y = pk2(OT[eb][4 * g4 + 2] * inv, OT[eb][4 * g4 + 3] * inv);
                *(GASP u32x2*)(op + eb * 32 + 8 * g4) = w; }
    }
}

template <int MODE>
__device__ __forceinline__ void sample_reduce(const float* slab, int S, const float* res, float* out, float scale, const float* STp, const float* gam, const float* bet,
                                              bf16_t* ob, float* STn, const float* c1, const float* c2, const bf16_t* resb = nullptr) {
    const int lane = threadIdx.x & 63, gw = blockIdx.x * 8 + (threadIdx.x >> 6);
    if (gw >= NS) return;
    const int row = NP + gw;
    f32x4 acc[4];
#pragma unroll
    for (int j = 0; j < 4; ++j) acc[j] = (f32x4){0.f, 0.f, 0.f, 0.f};
    for (int ks = 0; ks < S; ++ks) { const GASP f32x4* sp = (const GASP f32x4*)(slab + ((size_t)ks * NS + gw) * D) + lane;
#pragma unroll
        for (int j = 0; j < 4; ++j) acc[j] = acc[j] + sp[64 * j]; }
    float mu = 0.f, rstd = 1.f;
    if (STp) { const GASP f32x4* sp = (const GASP f32x4*)(STp + (size_t)row * 32); float s = 0.f, q = 0.f;
#pragma unroll
        for (int i = 0; i < 8; ++i) { const f32x4 v = sp[i]; s += v[0] + v[2]; q += v[1] + v[3]; }
        mu = s * (1.f / D); rstd = 1.f / sqrtf(q * (1.f / D) - mu * mu + LN_EPS); }
    if (MODE == 0) {
        const GASP f32x4* rp = (const GASP f32x4*)(res + (size_t)row * D) + lane;
        float s = 0.f, q = 0.f;
#pragma unroll
        for (int j = 0; j < 4; ++j) { f32x4 r;
            if (resb) { const u32x2 w = ((const GASP u32x2*)(resb + (size_t)row * D))[64 * j + lane];
                r = (f32x4){__uint_as_float(w.x << 16), __uint_as_float(w.x & 0xffff0000u), __uint_as_float(w.y << 16), __uint_as_float(w.y & 0xffff0000u)}; }
            else r = rp[64 * j];
            if (STp) r = (r - mu) * rstd * ((const GASP f32x4*)gam)[64 * j + lane] + ((const GASP f32x4*)bet)[64 * j + lane];
            const f32x4 o = r * ALPHA + acc[j] * scale;
            if (out) ((GASP f32x4*)(out + (size_t)row * D))[64 * j + lane] = o;
            if (ob) { u32x2 w; w.x = pk2(o[0], o[1]); w.y = pk2(o[2], o[3]); ((GASP u32x2*)(ob + (size_t)row * D))[64 * j + lane] = w; }
            s += (o[0] + o[1]) + (o[2] + o[3]); q += (o[0] * o[0] + o[1] * o[1]) + (o[2] * o[2] + o[3] * o[3]); }
        if (STn) { s = wave_sum(s); q = wave_sum(q);
            if (lane < 16) *(GASP f32x2*)(STn + (size_t)row * 32 + 2 * lane) = lane == 0 ? (f32x2){s, q} : (f32x2){0.f, 0.f}; }
    } else {
#pragma unroll
        for (int j = 0; j < 4; ++j) { const f32x4 y = ((acc[j] - ((const GASP f32x4*)c1)[64 * j + lane] * mu) * rstd + ((const GASP f32x4*)c2)[64 * j + lane]) * scale;
            u32x2 w; w.x = pk2(y[0], y[1]); w.y = pk2(y[2], y[3]); ((GASP u32x2*)(ob + (size_t)row * D))[64 * j + lane] = w; }
    }
}

__device__ __forceinline__ int queue_next(unsigned* ctr, LAS unsigned char* lds) {
    volatile LAS unsigned* w = (volatile LAS unsigned*)(lds + LDS_CTL);
    if (threadIdx.x == 0) w[0] = atomicAdd(ctr, 1u);
    __syncthreads();
    const int u = (int)w[0];
    __syncthreads();
    return u;
}

#define XB_TMO      128
#define XB_XCNT(j)  (256  + 64 * (j))
#define XB_XSUB(j)  (1280 + 64 * (j))
#define XB_XGEN(j)  (2304 + 64 * (j))
#define XB_TOP      3328
#define XB_TOPGEN   3392
#define XCD_BAR_WORDS 3456
#define XB_SPIN_CAP (1u << 18)
__device__ __forceinline__ unsigned xb_ld(unsigned* p)              { return __hip_atomic_load(p, __ATOMIC_RELAXED, __HIP_MEMORY_SCOPE_AGENT); }
__device__ __forceinline__ unsigned xb_add(unsigned* p, unsigned v) { return __hip_atomic_fetch_add(p, v, __ATOMIC_RELAXED, __HIP_MEMORY_SCOPE_AGENT); }
__device__ __forceinline__ unsigned xb_xcc_id() { return (unsigned)__builtin_amdgcn_s_getreg((3 << 11) | 20) & 0xFu; }
#define XB_SPIN(cond, bar) do { unsigned _sp = 0; while (cond) { __builtin_amdgcn_s_sleep(1); \
    if ((++_sp & 255u) == 0u) { if (xb_ld(&(bar)[XB_TMO])) break; if (_sp > XB_SPIN_CAP) { atomicAdd(&(bar)[XB_TMO], 1u); break; } } } } while (0)
struct XcdBarrier { unsigned* bar; unsigned x; volatile LAS unsigned* st; };
__device__ __forceinline__ XcdBarrier xcd_barrier_post(unsigned* bar, volatile LAS unsigned* st) {
    XcdBarrier b; b.bar = bar; b.x = xb_xcc_id(); b.st = st;
    if (threadIdx.x == 0) (void)xb_add(&bar[XB_XCNT(b.x)], 1u);
    return b;
}
__device__ __forceinline__ void xcd_barrier_complete(unsigned* bar, unsigned x, unsigned& nloc, unsigned& nx) {
    const unsigned G = gridDim.x * gridDim.y * gridDim.z;
    unsigned sum, cnt, mine, sp = 0u;
    for (;;) {
        sum = 0u; cnt = 0u; mine = 0u;
#pragma unroll
        for (unsigned j = 0; j < 16; ++j) { const unsigned c = xb_ld(&bar[XB_XCNT(j)]); sum += c; cnt += (c > 0u) ? 1u : 0u; mine = (j == x) ? c : mine; }
        if (sum == G) break;
        __builtin_amdgcn_s_sleep(1);
        if ((++sp & 255u) == 0u) { if (xb_ld(&bar[XB_TMO])) break; if (sp > XB_SPIN_CAP) { atomicAdd(&bar[XB_TMO], 1u); break; } }
    }
    nloc = mine > 0u ? mine : 1u; nx = cnt > 0u ? cnt : 1u;
}
__device__ __forceinline__ void xcd_barrier(const XcdBarrier& b) {
    asm volatile("s_waitcnt vmcnt(0)" ::: "memory");
    __syncthreads();
    if (threadIdx.x == 0) {
        unsigned* bar = b.bar;
        __builtin_amdgcn_s_waitcnt(0);
        unsigned nloc = b.st[0], nx = b.st[1];
        if (nloc == 0u) { xcd_barrier_complete(bar, b.x, nloc, nx); b.st[0] = nloc; b.st[1] = nx; }
        const unsigned old = xb_add(&bar[XB_XSUB(b.x)], 1u);
        const unsigned gen = old / nloc;
        if (old + 1u == (gen + 1u) * nloc) {
            __builtin_amdgcn_fence(__ATOMIC_RELEASE, "agent");
            asm volatile("s_waitcnt vmcnt(0)" ::: "memory");
            const unsigned og = xb_add(&bar[XB_TOP], 1u);
            const unsigned tg = og / nx;
            if (og + 1u == (tg + 1u) * nx) xb_add(&bar[XB_TOPGEN], 1u);
            else XB_SPIN(xb_ld(&bar[XB_TOPGEN]) == tg, bar);
            __builtin_amdgcn_fence(__ATOMIC_ACQUIRE, "agent");
            xb_add(&bar[XB_XGEN(b.x)], 1u);
            asm volatile("s_waitcnt vmcnt(0)" ::: "memory");
        } else {
            XB_SPIN(xb_ld(&bar[XB_XGEN(b.x)]) == gen, bar);
            __builtin_amdgcn_fence(__ATOMIC_ACQUIRE, "agent");
            asm volatile("s_waitcnt vmcnt(0)" ::: "memory");
        }
    }
    __syncthreads();
}

__global__ void __launch_bounds__(512, 2) mega(Params p) {
#if defined(__HIP_DEVICE_COMPILE__)
#pragma unroll
    for (int i = 0; i < 34; ++i) { __builtin_assume(!__builtin_amdgcn_is_shared((const void*)p.in[i])); __builtin_assume(!__builtin_amdgcn_is_private((const void*)p.in[i])); }
    __builtin_assume(!__builtin_amdgcn_is_shared((const void*)p.out)); __builtin_assume(!__builtin_amdgcn_is_private((const void*)p.out));
    __builtin_assume(!__builtin_amdgcn_is_shared((const void*)p.ws)); __builtin_assume(!__builtin_amdgcn_is_private((const void*)p.ws));
#endif
    extern __shared__ __attribute__((aligned(16))) unsigned char lds_raw[];
    LAS unsigned char* lds = (LAS unsigned char*)lds_raw;
    cg::grid_group grid = cg::this_grid();
    unsigned char* ws = p.ws;
    const int G = gridDim.x, bx = blockIdx.x;
    bf16_t* XB = (bf16_t*)(ws + O_XB); float* XF = (float*)(ws + O_XF); bf16_t* ACT = (bf16_t*)(ws + O_ACT);
    const int ph_lo = p.ph_lo, ph_hi = p.ph_hi;
    volatile LAS unsigned* stw = (volatile LAS unsigned*)(lds + LDS_CTL + 16);
    if (threadIdx.x < 2) stw[threadIdx.x] = 0u;
    __syncthreads();
    const XcdBarrier bar = xcd_barrier_post((unsigned*)(ws + O_BAR), stw);
    if (ph_lo < 0) grid.sync();
    {
        {
#define CASE(k) if (PH_ON(k) && ph_lo <= (k) && (k) < ph_hi)
#define SEAM(k) if (ph_lo <= (k) && (k) < ph_hi && ph_hi - ph_lo > 1) xcd_barrier(bar);
        for (int rep0 = 0; rep0 <= REP0; ++rep0) { CASE(0) phase_prep(p, lds); if (rep0 < REP0) grid.sync(); } SEAM(0)
        CASE(1) {
            { const int col = bx * 512 + threadIdx.x;
              if (col < NC12) { float s1 = 0.f, s2 = 0.f;
                  for (int kb = 0; kb < 16; ++kb) { s1 += ((const float*)(ws + O_C1P))[(size_t)kb * NC12 + col]; s2 += ((const float*)(ws + O_C2P))[(size_t)kb * NC12 + col]; }
                  ((float*)(ws + O_C1))[col] = s1; ((float*)(ws + O_C2))[col] = s2; } }
            { pg8::Gemm g{XB, (const bf16_t*)(ws + O_WGU1), M, 2 * FF, D, D}; pg8::StaticOrder S; S.init(M, 2 * FF, G, bx); pg8::EpiSwiGLU E{ACT, nullptr, nullptr, nullptr};
              pg8::gemm_phase<pg8::EpiSwiGLU, pg8::StaticOrder, true, true>(lds, g, S, E); }
            { const int off = (((M / 256) * (2 * FF / 256)) % G) & ~7; pg8::Gemm g{(const bf16_t*)(ws + O_MEMB), (const bf16_t*)(ws + O_WKV), 4096, 2 * D, D, D}; pg8::StaticOrder S; S.init(4096, 2 * D, G, (bx - off + G) % G);
              pg8::EpiMem E{p.out + OUT_MK, p.out + OUT_MV, (bf16_t*)(ws + O_MKB), (bf16_t*)(ws + O_MVB)};
              pg8::gemm_phase<pg8::EpiMem, pg8::StaticOrder, true, true>(lds, g, S, E); }
        } SEAM(1)
        CASE(2) { pg8::Gemm g{ACT, (const bf16_t*)(ws + O_WDN1), NP, D, FF, FF}; pg8::StaticOrder S; S.init(NP, D, G, bx); pg8::EpiResid E{nullptr, nullptr, M, nullptr, 0.5f, nullptr, nullptr, nullptr, XB, (float*)(ws + O_ST1), XB};
            pg8::gemm_phase<pg8::EpiResid, pg8::StaticOrder, true, true>(lds, g, S, E);
            { pg8::Gemm gs{ACT, (const bf16_t*)(ws + O_WDN1), M, D, 256, FF}; pg8::SplitKOrder SS{11, 256, G, bx}; pg8::EpiPartial EP{(float*)(ws + O_SLAB), 256}; pg8::gemm_phase<pg8::EpiPartial, pg8::SplitKOrder, true, true>(lds, gs, SS, EP); } } SEAM(2)
        CASE(3) sample_reduce<0>((const float*)(ws + O_SLAB), 11, nullptr, nullptr, 0.5f, nullptr, nullptr, nullptr, XB, (float*)(ws + O_ST1), nullptr, nullptr, XB); SEAM(3)
        CASE(4) { pg8::Gemm g{XB, (const bf16_t*)(ws + O_WIN), M, INC, D, D}; pg8::StaticOrder S; S.init(M, INC, G, bx);
            pg8::EpiIn E{(bf16_t*)(ws + O_QB), (bf16_t*)(ws + O_KB), (bf16_t*)(ws + O_VB), (bf16_t*)(ws + O_UB), (float*)(ws + O_GVF), p.out, 0.125f * LOG2E, (const float*)(ws + O_ST1), (const float*)(ws + O_C1) + C_IN, (const float*)(ws + O_C2) + C_IN, (float*)(ws + O_GST)};
            pg8::gemm_phase<pg8::EpiIn, pg8::StaticOrder, true, true>(lds, g, S, E); } SEAM(4)
        for (int rep5 = 0; rep5 <= REP5; ++rep5)
        CASE(5) {
            float lam;
            { const int lane = threadIdx.x & 63; const float a = wave_sum(p.in[12][lane] * p.in[13][lane]), c = wave_sum(p.in[14][lane] * p.in[15][lane]); lam = expf(a) - expf(c) + 0.2f; }
            unsigned* ctr = (unsigned*)(ws + O_CTR) + 4 * rep5;
            constexpr int NU_S = 128, NU_P = 1024, NU_G = (256 + 32) * 4;
            for (;;) {
                int u = queue_next(ctr, lds);
                if (u >= NU_S + NU_P + NU_G) break;
                const int parts = rep5 == REP5 ? 7 : REP5_PARTS;
                if (u < NU_S) { if (parts & 1) diff_unit<true>(p, lds, u >> 2, u & 3, 0, lam); continue; } u -= NU_S;
                if (u < NU_P) { const int qi = 15 - (u >> 6), bh = u & 63; if (rep5 == REP5) diff_unit<false>(p, lds, bh >> 2, bh & 3, qi, lam); else if (parts & 2) diff_unit<false, EXPER5>(p, lds, bh >> 2, bh & 3, qi, lam); continue; } u -= NU_P;
                if (parts & 4) { const int bc = u >> 2, g = u & 3; if (bc < 256) gate_unit(p, lds, bc * 128, 128, g, -1); else gate_unit(p, lds, NP + (bc - 256) * 32, 32, g, bc - 256); }
            }
            if (rep5 < REP5) grid.sync();
        } SEAM(5)
        CASE(6) { pg8::Gemm g{(const bf16_t*)(ws + O_MIX), (const bf16_t*)(ws + O_WOUT), NP, D, D, D}; pg8::StaticOrder S; S.init(NP, D, G, bx);
            pg8::EpiResid E{nullptr, nullptr, M, nullptr, 1.f, (const float*)(ws + O_ST1), p.in[9], p.in[10], XB, (float*)(ws + O_ST2), XB};
            pg8::gemm_phase<pg8::EpiResid, pg8::StaticOrder, true, true>(lds, g, S, E);
            { pg8::Gemm gs{(const bf16_t*)(ws + O_MIX), (const bf16_t*)(ws + O_WOUT), M, D, 256, D}; pg8::SplitKOrder SS{4, 256, G, bx}; pg8::EpiPartial EP{(float*)(ws + O_SLAB), 256}; pg8::gemm_phase<pg8::EpiPartial, pg8::SplitKOrder, true, true>(lds, gs, SS, EP); }
            { const int nb = 16 * 4 < G ? 16 * 4 : 0; if (bx >= nb) cvt_rows(p.in[4], (bf16_t*)(ws + O_MKB) + (size_t)4096 * D, (size_t)8192 * D / 8, (size_t)(bx - nb) * 512 + threadIdx.x, (size_t)(G - nb) * 512); } } SEAM(6)
        CASE(7) sample_reduce<0>((const float*)(ws + O_SLAB), 4, nullptr, nullptr, 1.f, (const float*)(ws + O_ST1), p.in[9], p.in[10], XB, (float*)(ws + O_ST2), nullptr, nullptr, XB); SEAM(7)
        CASE(8) { pg8::Gemm g{XB, (const bf16_t*)(ws + O_WQ), NP, D, D, D}; pg8::StaticOrder S; S.init(NP, D, G, bx); pg8::EpiBf16 E{(bf16_t*)(ws + O_QC), D, 0.0625f * LOG2E, (const float*)(ws + O_ST2), (const float*)(ws + O_C1) + C_Q, (const float*)(ws + O_C2) + C_Q};
            pg8::gemm_phase<pg8::EpiBf16, pg8::StaticOrder, true, true>(lds, g, S, E);
            { pg8::Gemm gs{XB, (const bf16_t*)(ws + O_WQ), M, D, 256, D}; pg8::SplitKOrder SS{4, 256, G, bx}; pg8::EpiPartial EP{(float*)(ws + O_SLAB), 256}; pg8::gemm_phase<pg8::EpiPartial, pg8::SplitKOrder, true, true>(lds, gs, SS, EP); }
            { const int nb = 16 * 4 < G ? 16 * 4 : 0; if (bx >= nb) cvt_rows(p.in[5], (bf16_t*)(ws + O_MVB) + (size_t)4096 * D, (size_t)8192 * D / 8, (size_t)(bx - nb) * 512 + threadIdx.x, (size_t)(G - nb) * 512); } } SEAM(8)
        CASE(15) sample_reduce<1>((const float*)(ws + O_SLAB), 4, nullptr, nullptr, 0.0625f * LOG2E, (const float*)(ws + O_ST2), nullptr, nullptr, (bf16_t*)(ws + O_QC), nullptr, (const float*)(ws + O_C1) + C_Q, (const float*)(ws + O_C2) + C_Q); SEAM(15)
        for (int rep9 = 0; rep9 <= REP9; ++rep9)
        CASE(9) {
            unsigned* ctr = (unsigned*)(ws + O_CTR) + 16 + 4 * rep9;
            constexpr int NU_P = 16 * 4 * 16, NU_S = 32 * 4;
            for (;;) {
                int u = queue_next(ctr, lds);
                if (u >= NU_P + NU_S) break;
                if (u < NU_P) cross_unit(p, lds, u >> 6, (u >> 4) & 3, u & 15);
                else { u -= NU_P; cross_unit(p, lds, 16 + (u >> 2), u & 3, 0); }
            }
            if (rep9 < REP9) grid.sync();
        } SEAM(9)
        CASE(10) { pg8::Gemm g{(const bf16_t*)(ws + O_OC), (const bf16_t*)(ws + O_WO), NP, D, D, D}; pg8::StaticOrder S; S.init(NP, D, G, bx);
            pg8::EpiResid E{nullptr, nullptr, M, nullptr, 1.f, (const float*)(ws + O_ST2), p.in[22], p.in[23], XB, (float*)(ws + O_ST3), XB};
            pg8::gemm_phase<pg8::EpiResid, pg8::StaticOrder, true, true>(lds, g, S, E);
            { pg8::Gemm gs{(const bf16_t*)(ws + O_OC), (const bf16_t*)(ws + O_WO), M, D, 256, D}; pg8::SplitKOrder SS{4, 256, G, bx}; pg8::EpiPartial EP{(float*)(ws + O_SLAB), 256}; pg8::gemm_phase<pg8::EpiPartial, pg8::SplitKOrder, true, true>(lds, gs, SS, EP); } } SEAM(10)
        CASE(11) sample_reduce<0>((const float*)(ws + O_SLAB), 4, nullptr, nullptr, 1.f, (const float*)(ws + O_ST2), p.in[22], p.in[23], XB, (float*)(ws + O_ST3), nullptr, nullptr, XB); SEAM(11)
        for (int rep12 = 0; rep12 <= REP12; ++rep12)
        CASE(12) { pg8::Gemm g{XB, (const bf16_t*)(ws + O_WGU2), M, 2 * FF, D, D}; pg8::StaticOrder S; S.init(M, 2 * FF, G, bx);
            pg8::EpiSwiGLU E{ACT, (const float*)(ws + O_ST3), (const float*)(ws + O_C1) + C_GU2, (const float*)(ws + O_C2) + C_GU2};
            pg8::gemm_phase<pg8::EpiSwiGLU, pg8::StaticOrder, true, true>(lds, g, S, E); if (rep12 < REP12) grid.sync(); } SEAM(12)
        CASE(13) { pg8::Gemm g{ACT, (const bf16_t*)(ws + O_WDN2), NP, D, FF, FF}; pg8::StaticOrder S; S.init(NP, D, G, bx);
            pg8::EpiResid E{nullptr, nullptr, M, nullptr, 0.5f, (const float*)(ws + O_ST3), p.in[28], p.in[29], XB, nullptr, XB};
            pg8::gemm_phase<pg8::EpiResid, pg8::StaticOrder, true, true>(lds, g, S, E);
            { pg8::Gemm gs{ACT, (const bf16_t*)(ws + O_WDN2), M, D, 256, FF}; pg8::SplitKOrder SS{11, 256, G, bx}; pg8::EpiPartial EP{(float*)(ws + O_SLAB), 256}; pg8::gemm_phase<pg8::EpiPartial, pg8::SplitKOrder, true, true>(lds, gs, SS, EP); } } SEAM(13)
        CASE(16) sample_reduce<0>((const float*)(ws + O_SLAB), 11, nullptr, nullptr, 0.5f, (const float*)(ws + O_ST3), p.in[28], p.in[29], XB, nullptr, nullptr, nullptr, XB); SEAM(16)
        CASE(14) phase_ln(XB, p.out + OUT_Y, nullptr, p.in[32], p.in[33]);
        }
    }
}

extern "C" void kernel_launch(void* const* d_in, const int* in_sizes, int n_in, void* d_out, int out_size, void* d_ws, size_t ws_size, hipStream_t stream) {
    static int grid = 0;
    if (grid == 0) {
        if (n_in != 34 || ws_size < O_END) { fprintf(stderr, "kernel_launch: unexpected problem (n_in %d, ws %zu < %zu)\n", n_in, ws_size, (size_t)O_END); grid = -1; return; }
        int dev = 0, cus = 0, per_cu = 0;
        hipGetDevice(&dev);
        hipDeviceGetAttribute(&cus, hipDeviceAttributeMultiprocessorCount, dev);
        if (hipFuncSetAttribute((const void*)mega, hipFuncAttributeMaxDynamicSharedMemorySize, LDS_BYTES) != hipSuccess) { fprintf(stderr, "kernel_launch: hipFuncSetAttribute failed\n"); grid = -1; return; }
        if (hipOccupancyMaxActiveBlocksPerMultiprocessor(&per_cu, (const void*)mega, 512, LDS_BYTES) != hipSuccess || per_cu < 1) { fprintf(stderr, "kernel_launch: occupancy query says %d\n", per_cu); per_cu = 1; }
        (void)hipGetLastError();
        grid = cus * 1;
    }
    if (grid < 0) return;
    Params p{};
    for (int i = 0; i < 34; ++i) p.in[i] = (const float*)d_in[i];
    p.out = (float*)d_out; p.ws = (unsigned char*)d_ws;
    if (hipMemsetAsync((char*)d_ws + O_BAR, 0, 16384, stream) != hipSuccess) { fprintf(stderr, "kernel_launch: memset of the barrier words failed\n"); return; }
#if ONE_LAUNCH
    p.ph_lo = 0; p.ph_hi = NPH;
    void* args[] = {&p};
    hipError_t e = hipLaunchCooperativeKernel((const void*)mega, dim3(grid), dim3(512), args, LDS_BYTES, stream);
    if (e != hipSuccess) fprintf(stderr, "cooperative launch failed: %s (grid %d)\n", hipGetErrorString(e), grid);
#else
    static const int order[NPH] = {0, 1, 2, 3, 4, 5, 6, 7, 8, 15, 9, 10, 11, 12, 13, 16, 14};
    for (int pi = 0; pi < NPH; ++pi) { const int ph = order[pi]; p.ph_lo = ph; p.ph_hi = ph + 1; hipLaunchKernelGGL(mega, dim3(grid), dim3(512), LDS_BYTES, stream, p); }
#endif
}
```

```cpp
#include <hip/hip_runtime.h>
#include <hip/hip_cooperative_groups.h>
#include <cstdio>
#include <cstdint>
namespace cg = cooperative_groups;

#ifndef ONE_LAUNCH
#define ONE_LAUNCH 1
#endif

#define LAS __attribute__((address_space(3)))
#define GASP __attribute__((address_space(1)))
typedef unsigned short bf16_t;
typedef short bf16x8 __attribute__((ext_vector_type(8)));
typedef short s16x4 __attribute__((ext_vector_type(4)));
typedef short v4i16_t __attribute__((ext_vector_type(4)));
typedef float f32x2 __attribute__((ext_vector_type(2)));
typedef float f32x4 __attribute__((ext_vector_type(4)));
typedef float f32x16 __attribute__((ext_vector_type(16)));
typedef unsigned u32x2 __attribute__((ext_vector_type(2)));
typedef unsigned u32x4 __attribute__((ext_vector_type(4)));

constexpr int D = 1024, NP = 32768, NS = 1024, M = NP + NS, SEQ = 2048, PAST = 4096, DECS = 32;
constexpr int FF = 2816, INC = 2560;
constexpr float LN_EPS = 1e-5f, ALPHA = 1.189207115002721f, LOG2E = 1.4426950408889634f;
constexpr int NPH = 17;
#ifndef PH_MASK
#define PH_MASK 0x1ffff
#endif
#define PH_ON(k) (((PH_MASK) >> (k)) & 1)
#ifndef REP5
#define REP5 0
#endif
#ifndef REP12
#define REP12 0
#endif
#ifndef REP0
#define REP0 0
#endif
#ifndef EXPER5
#define EXPER5 0
#endif
#ifndef REP9
#define REP9 0
#endif
#ifndef REP5_PARTS
#define REP5_PARTS 7
#endif

constexpr size_t OUT_Y = 0, OUT_KP = 34603008, OUT_VP = 51380224, OUT_MK = 68157440, OUT_MV = 72351744, OUT_KS = 76546048, OUT_VS = 77070336, OUT_GV = 77594624;

constexpr size_t O_CTR = 0;
constexpr size_t O_WGU1 = 4096;
constexpr size_t O_WDN1 = O_WGU1 + (size_t)2 * FF * D * 2;
constexpr size_t O_WIN = O_WDN1 + (size_t)D * FF * 2;
constexpr size_t O_WOUT = O_WIN + (size_t)INC * D * 2;
constexpr size_t O_WQ = O_WOUT + (size_t)D * D * 2;
constexpr size_t O_WKV = O_WQ + (size_t)D * D * 2;
constexpr size_t O_WO = O_WKV + (size_t)2 * D * D * 2;
constexpr size_t O_WGU2 = O_WO + (size_t)D * D * 2;
constexpr size_t O_WDN2 = O_WGU2 + (size_t)2 * FF * D * 2;
constexpr size_t O_WSB = O_WDN2 + (size_t)D * FF * 2;
constexpr size_t O_XB = O_WSB + 4 * 128 * 128 * 2;
constexpr size_t O_XF = O_XB + (size_t)M * D * 2;
constexpr size_t O_ACT = O_XF + (size_t)M * D * 4;
constexpr size_t O_MEMB = O_ACT + (size_t)M * FF * 2;
constexpr size_t O_MKB = O_MEMB + (size_t)4096 * D * 2;
constexpr size_t O_MVB = O_MKB + (size_t)48 * 256 * D * 2;
constexpr size_t O_QB = O_MVB + (size_t)48 * 256 * D * 2;
constexpr size_t O_KB = O_QB + (size_t)M * 512 * 2;
constexpr size_t O_VB = O_KB + (size_t)M * 512 * 2;
constexpr size_t O_UB = O_VB + (size_t)M * 512 * 2;
constexpr size_t O_GVF = O_UB + (size_t)M * 512 * 2;
constexpr size_t O_MIX = O_GVF + (size_t)M * 512 * 4;
constexpr size_t O_ST1 = O_MIX + (size_t)M * D * 2;
constexpr size_t O_ST2 = O_ST1 + (size_t)M * 128;
constexpr size_t O_ST3 = O_ST2 + (size_t)M * 128;
constexpr int NC12 = INC + D + 2 * FF;
constexpr int C_IN = 0, C_Q = INC, C_GU2 = INC + D;
constexpr size_t O_C1P = O_ST3 + (size_t)M * 128;
constexpr size_t O_C2P = O_C1P + (size_t)16 * NC12 * 4;
constexpr size_t O_C1 = O_C2P + (size_t)16 * NC12 * 4;
constexpr size_t O_C2 = O_C1 + (size_t)NC12 * 4;
constexpr size_t O_GST = O_C2 + (size_t)NC12 * 4;
constexpr size_t O_BAR = O_GST + (size_t)M * 64;
constexpr size_t O_SLAB = O_BAR + 16384;
constexpr size_t O_END = O_SLAB + (size_t)11 * NS * D * 4;
constexpr size_t O_QC = O_ACT, O_OC = O_ACT + (size_t)M * D * 2;

constexpr int LDS_BYTES = 147456;
constexpr int LDS_CTL = 144 * 1024 - 256;

struct Params { const float* in[34]; float* out; unsigned char* ws; int ph_lo, ph_hi; };

__device__ __forceinline__ unsigned pk2(float lo, float hi) {
    typedef __bf16 b2 __attribute__((ext_vector_type(2)));
    f32x2 v = {lo, hi}; b2 b = __builtin_convertvector(v, b2); return __builtin_bit_cast(unsigned, b);
}
__device__ __forceinline__ float wave_sum(float v) {
#pragma unroll
    for (int o = 1; o < 64; o <<= 1) v += __shfl_xor(v, o);
    return v;
}
__device__ __forceinline__ float fexp2(float x) { return __builtin_amdgcn_exp2f(x); }
__device__ __forceinline__ float frcp(float x) { return __builtin_amdgcn_rcpf(x); }
__device__ __forceinline__ float silu_f(float g) { return g * frcp(1.f + fexp2(-g * LOG2E)); }
__device__ __forceinline__ float gelu_f(float x) { const float u = 0.7978845608028654f * (x + 0.044715f * x * x * x); return x * frcp(1.f + fexp2(-2.f * LOG2E * u)); }

namespace pg8 {
constexpr int BM = 256, BK = 64, HALF = 128, HTB = HALF * BK * 2, STAGE_BYTES = 8 * HTB, NXCD = 8, WGM = 8;
__host__ __device__ __forceinline__ int lds_byte(int r, int c) { const int st = (r >> 4) * 2 + (c >> 5), rr = r & 15, cc = c & 31, ob = rr * 64 + cc * 2; return st * 1024 + (ob ^ (((ob >> 9) & 1) << 5)); }
__host__ __device__ __forceinline__ void stage_rc(int b, int& R, int& C) { const int st = b / 1024, sb = b % 1024, swz = sb ^ (((sb >> 9) & 1) << 5); R = (st >> 1) * 16 + swz / 64; C = (st & 1) * 32 + (swz % 64) / 2; }
__host__ __device__ __forceinline__ int perm32(int rho) { const int n = rho >> 4, i = rho & 15; return 8 * (i >> 2) + 4 * n + (i & 3); }
struct Unit { int pm, pn, kofs; };
struct Gemm { const bf16_t* A; const bf16_t* Bt; int M, N, K; int ldk; };
struct StaticOrder {
    int nM, nN, nwg, G, c;
    __host__ __device__ void init(int M_, int N_, int G_, int c_) { nM = M_ / BM; nN = N_ / BM; nwg = nM * nN; G = G_; c = c_; }
    __host__ __device__ bool next(int i, Unit& u) const {
        const long L = (long)i * G + c; if (L >= nwg) return false;
        int wgid = (int)L; { const int q = nwg / NXCD, r = nwg % NXCD, xcd = wgid % NXCD, off = wgid / NXCD; wgid = (xcd < r ? xcd * (q + 1) : r * (q + 1) + (xcd - r) * q) + off; }
        const int nig = WGM * nN, gid = wgid / nig, fm = gid * WGM, gsz = (nM - fm) < WGM ? (nM - fm) : WGM;
        u.pm = fm + ((wgid % nig) % gsz); u.pn = (wgid % nig) / gsz; u.kofs = 0; return true;
    }
};
template <class Epi, class Sched, bool ALIGN_EPI = false, bool SP2 = false>
__device__ __forceinline__ void gemm_phase(LAS unsigned char* lds, const Gemm g, const Sched& S, const Epi& E) {
    int tid = threadIdx.x; asm volatile("" : "+v"(tid));
    const int wid = __builtin_amdgcn_readfirstlane(tid >> 6), lane = tid & 63, wr = wid >> 2, wc = wid & 3, fr = lane & 15, fq = lane >> 4;
    const int K = g.ldk, nt = g.K / BK;
    unsigned voffA[2], voffB[2];
#pragma unroll
    for (int i = 0; i < 2; ++i) { int R, C; stage_rc(tid * 16 + i * 8192, R, C); const int Rb = Epi::PERM ? ((R & ~31) + perm32(R & 31)) : R;
        voffA[i] = (unsigned)(R * K + C) * 2u; voffB[i] = (unsigned)(Rb * K + C) * 2u; }
    const size_t kstep = (size_t)(BK * 2);
    const size_t hstep = (size_t)HALF * K * 2;
    const size_t tstep = 2 * hstep;
    const unsigned ldsw = (unsigned)wid * 1024u;
    const int aoff = lds_byte(wr * 64 + fr, fq * 8), boff = lds_byte(wc * 32 + fr, fq * 8);
#define PG8_SA(b, h) (((b) * 2 + (h)) * HTB)
#define PG8_SB(b, h) ((4 + (b) * 2 + (h)) * HTB)
#define PG8_STAGE(bufoff, gbase, voff) do { _Pragma("unroll") for (int _i = 0; _i < 2; ++_i) \
        __builtin_amdgcn_global_load_lds((const unsigned*)((const char*)(gbase) + (voff)[_i]), (LAS unsigned*)(lds + (bufoff) + ldsw + _i * 8192), 16, 0, 0); } while (0)
#define PG8_LDA(dst, b, h) do { _Pragma("unroll") for (int m = 0; m < 4; ++m) _Pragma("unroll") for (int k = 0; k < 2; ++k) dst[m][k] = *(const LAS bf16x8*)(lds + PG8_SA(b, h) + aoff + m * 2048 + k * 1024); } while (0)
#define PG8_LDB(dst, b, h) do { _Pragma("unroll") for (int n = 0; n < 2; ++n) _Pragma("unroll") for (int k = 0; k < 2; ++k) dst[n][k] = *(const LAS bf16x8*)(lds + PG8_SB(b, h) + boff + n * 2048 + k * 1024); } while (0)
#define PG8_MMA(ai, bj, At, Bt) do { __builtin_amdgcn_s_setprio(1); _Pragma("unroll") for (int m = 0; m < 4; ++m) _Pragma("unroll") for (int n = 0; n < 2; ++n) _Pragma("unroll") for (int k = 0; k < 2; ++k) \
        acc[ai][bj][m][n] = __builtin_amdgcn_mfma_f32_16x16x32_bf16(Bt[n][k], At[m][k], acc[ai][bj][m][n], 0, 0, 0); __builtin_amdgcn_s_setprio(0); } while (0)
#define PG8_WAIT_V(n) asm volatile("s_waitcnt vmcnt(" #n ")" ::: "memory")
#define PG8_WAIT_L(n) asm volatile("s_waitcnt lgkmcnt(" #n ")" ::: "memory")
#define PG8_BAR __builtin_amdgcn_s_barrier()
#define PG8_SCHED __builtin_amdgcn_sched_barrier(0)
    Unit cur, nxt; int ui = 0;
    if (!S.next(0, cur)) return;
    f32x4 acc[2][2][4][2];
#pragma unroll
    for (int a = 0; a < 2; ++a)
#pragma unroll
        for (int b = 0; b < 2; ++b)
#pragma unroll
            for (int m = 0; m < 4; ++m)
#pragma unroll
                for (int n = 0; n < 2; ++n) acc[a][b][m][n] = (f32x4){0.f, 0.f, 0.f, 0.f};
    bf16x8 At[4][2], B0[2][2], B1[2][2];
    const char* cA = (const char*)g.A + (size_t)cur.pm * tstep + (size_t)cur.kofs * 2; const char* cB = (const char*)g.Bt + (size_t)cur.pn * tstep + (size_t)cur.kofs * 2;
    if constexpr (SP2) {
        PG8_STAGE(PG8_SB(0, 0), cB, voffB); PG8_STAGE(PG8_SB(0, 1), cB + hstep, voffB); PG8_STAGE(PG8_SA(0, 0), cA, voffA); PG8_STAGE(PG8_SA(0, 1), cA + hstep, voffA);
        if (wr == 1) PG8_BAR;
        PG8_WAIT_V(2); PG8_BAR;
        PG8_STAGE(PG8_SB(1, 0), cB + kstep, voffB); PG8_STAGE(PG8_SA(1, 0), cA + kstep, voffA); PG8_STAGE(PG8_SB(1, 1), cB + hstep + kstep, voffB);
        PG8_WAIT_V(6); PG8_BAR;
    } else {
        PG8_STAGE(PG8_SB(0, 0), cB, voffB); PG8_STAGE(PG8_SA(0, 0), cA, voffA); PG8_STAGE(PG8_SB(0, 1), cB + hstep, voffB); PG8_STAGE(PG8_SA(0, 1), cA + hstep, voffA);
        if (wr == 1) PG8_BAR;
        PG8_WAIT_V(4); PG8_BAR;
        PG8_STAGE(PG8_SB(1, 0), cB + kstep, voffB); PG8_STAGE(PG8_SA(1, 0), cA + kstep, voffA); PG8_STAGE(PG8_SB(1, 1), cB + hstep + kstep, voffB);
        PG8_WAIT_V(6); PG8_BAR;
    }
    for (;;) {
        const bool has_next = S.next(ui + 1, nxt);
        const char* nA = has_next ? (const char*)g.A + (size_t)nxt.pm * tstep + (size_t)nxt.kofs * 2 : cA; const char* nB = has_next ? (const char*)g.Bt + (size_t)nxt.pn * tstep + (size_t)nxt.kofs * 2 : cB;
        for (int t = 0; t < nt; t += 2) {
            const bool last = (t == nt - 2);
            const char* a1 = cA + (size_t)(t + 1) * kstep;
            const char* a2 = last ? nA : cA + (size_t)(t + 2) * kstep; const char* b2 = last ? nB : cB + (size_t)(t + 2) * kstep;
            const char* a3 = a2 + kstep; const char* b3 = b2 + kstep;
            if constexpr (SP2) {
            PG8_LDB(B0, 0, 0); PG8_LDB(B1, 0, 1); PG8_SCHED; PG8_LDA(At, 0, 0); PG8_STAGE(PG8_SA(1, 1), a1 + hstep, voffA);
            PG8_WAIT_V(8); PG8_WAIT_L(0); PG8_BAR; PG8_MMA(0, 0, At, B0); PG8_MMA(0, 1, At, B1); PG8_BAR; PG8_SCHED;
            PG8_LDA(At, 0, 1); PG8_STAGE(PG8_SB(0, 0), b2, voffB); PG8_STAGE(PG8_SB(0, 1), b2 + hstep, voffB); PG8_STAGE(PG8_SA(0, 0), a2, voffA);
            PG8_WAIT_V(8); PG8_WAIT_L(0); PG8_BAR; PG8_MMA(1, 0, At, B0); PG8_MMA(1, 1, At, B1); PG8_BAR; PG8_SCHED;
            PG8_LDB(B0, 1, 0); PG8_LDB(B1, 1, 1); PG8_SCHED; PG8_LDA(At, 1, 0); PG8_STAGE(PG8_SA(0, 1), a2 + hstep, voffA);
            PG8_WAIT_V(8); PG8_WAIT_L(0); PG8_BAR; PG8_MMA(0, 0, At, B0); PG8_MMA(0, 1, At, B1); PG8_BAR; PG8_SCHED;
            PG8_LDA(At, 1, 1); PG8_STAGE(PG8_SB(1, 0), b3, voffB); PG8_STAGE(PG8_SB(1, 1), b3 + hstep, voffB); PG8_STAGE(PG8_SA(1, 0), a3, voffA);
            PG8_WAIT_V(8); PG8_WAIT_L(0); PG8_BAR; PG8_MMA(1, 0, At, B0); PG8_MMA(1, 1, At, B1); PG8_BAR; PG8_SCHED;
            } else {
            PG8_LDB(B0, 0, 0); PG8_SCHED; PG8_LDA(At, 0, 0); PG8_STAGE(PG8_SA(1, 1), a1 + hstep, voffA);
            PG8_WAIT_L(8); PG8_BAR; PG8_WAIT_L(0); PG8_MMA(0, 0, At, B0); PG8_BAR; PG8_SCHED;
            PG8_LDB(B1, 0, 1); PG8_STAGE(PG8_SB(0, 0), b2, voffB);
            PG8_BAR; PG8_WAIT_L(0); PG8_MMA(0, 1, At, B1); PG8_BAR;
            PG8_LDA(At, 0, 1); PG8_STAGE(PG8_SA(0, 0), a2, voffA);
            PG8_BAR; PG8_WAIT_L(0); PG8_MMA(1, 0, At, B0); PG8_BAR; PG8_SCHED;
            PG8_STAGE(PG8_SB(0, 1), b2 + hstep, voffB);
            PG8_WAIT_V(6); PG8_BAR; PG8_MMA(1, 1, At, B1); PG8_BAR;
            PG8_LDB(B0, 1, 0); PG8_SCHED; PG8_LDA(At, 1, 0); PG8_STAGE(PG8_SA(0, 1), a2 + hstep, voffA);
            PG8_WAIT_L(8); PG8_BAR; PG8_WAIT_L(0); PG8_MMA(0, 0, At, B0); PG8_BAR; PG8_SCHED;
            PG8_LDB(B1, 1, 1); PG8_STAGE(PG8_SB(1, 0), b3, voffB);
            PG8_BAR; PG8_WAIT_L(0); PG8_MMA(0, 1, At, B1); PG8_BAR;
            PG8_LDA(At, 1, 1); PG8_STAGE(PG8_SA(1, 0), a3, voffA);
            PG8_BAR; PG8_WAIT_L(0); PG8_MMA(1, 0, At, B0); PG8_BAR; PG8_SCHED;
            PG8_STAGE(PG8_SB(1, 1), b3 + hstep, voffB);
            PG8_WAIT_V(6); PG8_BAR; PG8_MMA(1, 1, At, B1); PG8_BAR;
            }
        }
        if constexpr (ALIGN_EPI) { if (wr == 0) PG8_BAR; }
        E(acc, cur, wr, wc, fr, fq, lds);
        if (!has_next) break;
#pragma unroll
        for (int a = 0; a < 2; ++a)
#pragma unroll
            for (int b = 0; b < 2; ++b)
#pragma unroll
                for (int m = 0; m < 4; ++m)
#pragma unroll
                    for (int n = 0; n < 2; ++n) acc[a][b][m][n] = (f32x4){0.f, 0.f, 0.f, 0.f};
        cur = nxt; cA = nA; cB = nB; ++ui;
        if constexpr (ALIGN_EPI) { if (wr == 1) PG8_BAR; }
    }
    PG8_WAIT_V(0);
    if constexpr (!ALIGN_EPI) { if (wr == 0) PG8_BAR; }
    PG8_BAR;
#undef PG8_SA
#undef PG8_SB
#undef PG8_STAGE
#undef PG8_LDA
#undef PG8_LDB
#undef PG8_MMA
#undef PG8_WAIT_V
#undef PG8_WAIT_L
#undef PG8_BAR
#undef PG8_SCHED
}

typedef f32x4 Acc[2][2][4][2];
constexpr int SL_OFF = STAGE_BYTES;
__device__ __forceinline__ void row_stats_table(LAS unsigned char* lds, const float* ST, int pm) {
    const int tid = threadIdx.x;
    if (tid < 256) { const GASP f32x4* sp = (const GASP f32x4*)(ST + (size_t)(pm * BM + tid) * 32); float s = 0.f, q = 0.f;
#pragma unroll
        for (int i = 0; i < 8; ++i) { const f32x4 v = sp[i]; s += v[0] + v[2]; q += v[1] + v[3]; }
        const float mu = s * (1.f / D), var = q * (1.f / D) - mu * mu;
        ((LAS f32x2*)(lds + SL_OFF))[tid] = (f32x2){mu, 1.f / sqrtf(var + LN_EPS)}; }
    asm volatile("s_waitcnt lgkmcnt(0)" ::: "memory"); __builtin_amdgcn_s_barrier(); asm volatile("" ::: "memory");
}
template <bool PERM>
__device__ __forceinline__ void ln_fold_fix(Acc& acc, const Unit& u, int wr, int wc, int fr, int fq, const float* c1, const float* c2, LAS unsigned char* lds) {
    const LAS f32x2* SL = (const LAS f32x2*)(lds + SL_OFF);
#pragma unroll
    for (int bj = 0; bj < 2; ++bj)
#pragma unroll
        for (int n = 0; n < 2; ++n) { const int c = u.pn * BM + bj * HALF + wc * 32 + (PERM ? 8 * fq + 4 * n : 16 * n + 4 * fq);
            const f32x4 a1 = *(const GASP f32x4*)(c1 + c), a2 = *(const GASP f32x4*)(c2 + c);
#pragma unroll
            for (int ai = 0; ai < 2; ++ai)
#pragma unroll
                for (int m = 0; m < 4; ++m) { const f32x2 st = SL[ai * HALF + wr * 64 + m * 16 + fr]; acc[ai][bj][m][n] = (acc[ai][bj][m][n] - a1 * st[0]) * st[1] + a2; } }
}

struct EpiSwiGLU {
    static constexpr bool PERM = true;
    bf16_t* O; const float* ST; const float* c1; const float* c2;
    __device__ __forceinline__ void operator()(Acc& acc, const Unit& u, int wr, int wc, int fr, int fq, LAS unsigned char* lds) const {
        if (ST) { row_stats_table(lds, ST, u.pm); ln_fold_fix<true>(acc, u, wr, wc, fr, fq, c1, c2, lds); }
        const int row0 = u.pm * BM + wr * 64 + fr, col0 = u.pn * 128 + wc * 32 + 8 * fq;
#pragma unroll
        for (int ai = 0; ai < 2; ++ai)
#pragma unroll
            for (int m = 0; m < 4; ++m) {
                const f32x4 g0 = acc[ai][0][m][0], g1 = acc[ai][0][m][1], u0 = acc[ai][1][m][0], u1 = acc[ai][1][m][1];
                u32x4 w;
                w.x = pk2(silu_f(g0[0]) * u0[0], silu_f(g0[1]) * u0[1]); w.y = pk2(silu_f(g0[2]) * u0[2], silu_f(g0[3]) * u0[3]);
                w.z = pk2(silu_f(g1[0]) * u1[0], silu_f(g1[1]) * u1[1]); w.w = pk2(silu_f(g1[2]) * u1[2], silu_f(g1[3]) * u1[3]);
                *(GASP u32x4*)(O + (size_t)(row0 + ai * HALF + m * 16) * FF + col0) = w;
            }
    }
};
struct EpiResid {
    static constexpr bool PERM = false;
    const float* res0; const float* res1; int split; float* out; float scale;
    const float* STp; const float* gam; const float* bet; bf16_t* ob; float* STn;
    const bf16_t* resb;
    __device__ __forceinline__ void operator()(Acc& acc, const Unit& u, int wr, int wc, int fr, int fq, LAS unsigned char* lds) const {
        const int col0 = u.pn * BM + wc * 32 + 4 * fq;
        if (STp) row_stats_table(lds, STp, u.pm);
        const LAS f32x2* SL = (const LAS f32x2*)(lds + SL_OFF);
        f32x4 gg[2][2], bb[2][2];
        if (STp) {
#pragma unroll
            for (int bj = 0; bj < 2; ++bj)
#pragma unroll
                for (int n = 0; n < 2; ++n) { gg[bj][n] = *(const GASP f32x4*)(gam + col0 + bj * HALF + n * 16); bb[bj][n] = *(const GASP f32x4*)(bet + col0 + bj * HALF + n * 16); }
        }
#pragma unroll
        for (int ai = 0; ai < 2; ++ai)
#pragma unroll
            for (int m = 0; m < 4; ++m) {
                const int rl = ai * HALF + wr * 64 + m * 16 + fr, row = u.pm * BM + rl;
                const float* rp = (row < split) ? res0 + (size_t)row * D : res1 + (size_t)(row - split) * D;
                float* op = out + (size_t)row * D;
                f32x2 st = (f32x2){0.f, 1.f}; if (STp) st = SL[rl];
                float s = 0.f, q = 0.f;
#pragma unroll
                for (int bj = 0; bj < 2; ++bj)
#pragma unroll
                    for (int n = 0; n < 2; ++n) { const int c = col0 + bj * HALF + n * 16; f32x4 r;
                        if (resb) { const u32x2 w = *(const GASP u32x2*)(resb + (size_t)row * D + c);
                            r = (f32x4){__uint_as_float(w.x << 16), __uint_as_float(w.x & 0xffff0000u), __uint_as_float(w.y << 16), __uint_as_float(w.y & 0xffff0000u)}; }
                        else r = *(const GASP f32x4*)(rp + c);
                        if (STp) r = (r - st[0]) * st[1] * gg[bj][n] + bb[bj][n];
                        const f32x4 o = r * ALPHA + acc[ai][bj][m][n] * scale;
                        if (out) *(GASP f32x4*)(op + c) = o;
                        if (ob) { u32x2 w; w.x = pk2(o[0], o[1]); w.y = pk2(o[2], o[3]); *(GASP u32x2*)(ob + (size_t)row * D + c) = w; }
                        s += (o[0] + o[1]) + (o[2] + o[3]); q += (o[0] * o[0] + o[1] * o[1]) + (o[2] * o[2] + o[3] * o[3]); }
                if (STn) { s += __shfl_xor(s, 16); s += __shfl_xor(s, 32); q += __shfl_xor(q, 16); q += __shfl_xor(q, 32);
                    if (fq == 0) *(GASP f32x2*)(STn + (size_t)row * 32 + (u.pn * 4 + wc) * 2) = (f32x2){s, q}; }
            }
    }
};
struct EpiBf16 {
    static constexpr bool PERM = true;
    bf16_t* O; int ldc; float scale; const float* ST; const float* c1; const float* c2;
    __device__ __forceinline__ void operator()(Acc& acc, const Unit& u, int wr, int wc, int fr, int fq, LAS unsigned char* lds) const {
        if (ST) { row_stats_table(lds, ST, u.pm); ln_fold_fix<true>(acc, u, wr, wc, fr, fq, c1, c2, lds); }
        const int row0 = u.pm * BM + wr * 64 + fr, col0 = u.pn * BM + wc * 32 + 8 * fq;
#pragma unroll
        for (int ai = 0; ai < 2; ++ai)
#pragma unroll
            for (int m = 0; m < 4; ++m)
#pragma unroll
                for (int bj = 0; bj < 2; ++bj) { const f32x4 v0 = acc[ai][bj][m][0] * scale, v1 = acc[ai][bj][m][1] * scale;
                    u32x4 w; w.x = pk2(v0[0], v0[1]); w.y = pk2(v0[2], v0[3]); w.z = pk2(v1[0], v1[1]); w.w = pk2(v1[2], v1[3]);
                    *(GASP u32x4*)(O + (size_t)(row0 + ai * HALF + m * 16) * ldc + col0 + bj * HALF) = w; }
    }
};
struct EpiMem {
    static constexpr bool PERM = true;
    float* outk; float* outv; bf16_t* kb; bf16_t* vb;
    __device__ __forceinline__ void operator()(Acc& acc, const Unit& u, int wr, int wc, int fr, int fq, LAS unsigned char*) const {
        const int row0 = u.pm * BM + wr * 64 + fr; int colt = u.pn * BM; const bool isv = colt >= D; if (isv) colt -= D;
        float* of = isv ? outv : outk; bf16_t* ob = isv ? vb : kb;
        const int col0 = colt + wc * 32 + 8 * fq;
#pragma unroll
        for (int ai = 0; ai < 2; ++ai)
#pragma unroll
            for (int m = 0; m < 4; ++m)
#pragma unroll
                for (int bj = 0; bj < 2; ++bj) { const f32x4 v0 = acc[ai][bj][m][0], v1 = acc[ai][bj][m][1];
                    const size_t o = (size_t)(row0 + ai * HALF + m * 16) * D + col0 + bj * HALF;
                    *(GASP f32x4*)(of + o) = v0; *(GASP f32x4*)(of + o + 4) = v1;
                    u32x4 w; w.x = pk2(v0[0], v0[1]); w.y = pk2(v0[2], v0[3]); w.z = pk2(v1[0], v1[1]); w.w = pk2(v1[2], v1[3]);
                    *(GASP u32x4*)(ob + o) = w; }
    }
};
struct EpiIn {
    static constexpr bool PERM = true;
    bf16_t *qb, *kb, *vb, *ub; bf16_t* gvf; float* out; float qscale; const float* ST; const float* c1; const float* c2; float* gst;
    __device__ __forceinline__ void operator()(Acc& acc, const Unit& u, int wr, int wc, int fr, int fq, LAS unsigned char* lds) const {
        row_stats_table(lds, ST, u.pm); ln_fold_fix<true>(acc, u, wr, wc, fr, fq, c1, c2, lds);
        const int row0 = u.pm * BM + wr * 64 + fr; const int sec = u.pn >> 1; const int col0 = (u.pn & 1) * BM + wc * 32 + 8 * fq;
#pragma unroll
        for (int ai = 0; ai < 2; ++ai)
#pragma unroll
            for (int m = 0; m < 4; ++m) {
                const int row = row0 + ai * HALF + m * 16;
                float gs = 0.f, gq = 0.f;
#pragma unroll
                for (int bj = 0; bj < 2; ++bj) {
                    f32x4 v0 = acc[ai][bj][m][0], v1 = acc[ai][bj][m][1];
                    const size_t o = (size_t)row * 512 + col0 + bj * HALF;
                    if (sec == 0) { v0 = v0 * qscale; v1 = v1 * qscale; }
                    if (sec == 1) { float* of = (row < NP ? out + OUT_KP + (size_t)row * 512 : out + OUT_KS + (size_t)(row - NP) * 512) + col0 + bj * HALF; *(GASP f32x4*)of = v0; *(GASP f32x4*)(of + 4) = v1; }
                    if (sec == 2) { float* of = (row < NP ? out + OUT_VP + (size_t)row * 512 : out + OUT_VS + (size_t)(row - NP) * 512) + col0 + bj * HALF; *(GASP f32x4*)of = v0; *(GASP f32x4*)(of + 4) = v1; }
                    if (sec >= 3) {
#pragma unroll
                        for (int j = 0; j < 4; ++j) { v0[j] = gelu_f(v0[j]); v1[j] = gelu_f(v1[j]); }
                    }
                    if (sec == 4) { { u32x4 w; w.x = pk2(v0[0], v0[1]); w.y = pk2(v0[2], v0[3]); w.z = pk2(v1[0], v1[1]); w.w = pk2(v1[2], v1[3]); *(GASP u32x4*)(gvf + o) = w; }
                        gs += ((v0[0] + v0[1]) + (v0[2] + v0[3])) + ((v1[0] + v1[1]) + (v1[2] + v1[3]));
                        gq += ((v0[0] * v0[0] + v0[1] * v0[1]) + (v0[2] * v0[2] + v0[3] * v0[3])) + ((v1[0] * v1[0] + v1[1] * v1[1]) + (v1[2] * v1[2] + v1[3] * v1[3])); }
                    else {
                        u32x4 w; w.x = pk2(v0[0], v0[1]); w.y = pk2(v0[2], v0[3]); w.z = pk2(v1[0], v1[1]); w.w = pk2(v1[2], v1[3]);
                        if (sec == 0) *(GASP u32x4*)(qb + o) = w; else if (sec == 1) *(GASP u32x4*)(kb + o) = w; else if (sec == 2) *(GASP u32x4*)(vb + o) = w; else *(GASP u32x4*)(ub + o) = w;
                    }
                }
                if (sec == 4) { gs += __shfl_xor(gs, 16); gs += __shfl_xor(gs, 32); gq += __shfl_xor(gq, 16); gq += __shfl_xor(gq, 32);
                    if (fq == 0) *(GASP f32x2*)(gst + (size_t)row * 16 + ((u.pn & 1) * 4 + wc) * 2) = (f32x2){gs, gq}; }
            }
    }
};

struct SplitKOrder {
    int S, Ks, G, c;
    __host__ __device__ bool next(int i, Unit& u) const {
        const int L = i * G + c; if (L >= 16 * S) return false;
        const int tile = L / S, ks = L - tile * S; u.pm = NP / BM + (tile >> 2); u.pn = tile & 3; u.kofs = ks * Ks; return true;
    }
};
struct EpiPartial {
    static constexpr bool PERM = false;
    float* slab; int Ks;
    __device__ __forceinline__ void operator()(Acc& acc, const Unit& u, int wr, int wc, int fr, int fq, LAS unsigned char*) const {
        float* base = slab + (size_t)(u.kofs / Ks) * NS * D; const int col0 = u.pn * BM + wc * 32 + 4 * fq;
#pragma unroll
        for (int ai = 0; ai < 2; ++ai)
#pragma unroll
            for (int m = 0; m < 4; ++m) { float* op = base + (size_t)(u.pm * BM - NP + ai * HALF + wr * 64 + m * 16 + fr) * D + col0;
#pragma unroll
                for (int bj = 0; bj < 2; ++bj)
#pragma unroll
                    for (int n = 0; n < 2; ++n) *(GASP f32x4*)(op + bj * HALF + n * 16) = acc[ai][bj][m][n]; }
    }
};
}

__device__ __forceinline__ void transpose_item(const float* W, int K, int N, bf16_t* WT, int item, int gu, LAS float* tile,
                                               const float* gam = nullptr, const float* bet = nullptr, float* c1p = nullptr, float* c2p = nullptr) {
    const int tid = threadIdx.x, nblk = N / 64, kb = item / nblk, nb = item % nblk, k0 = kb * 64, n0 = nb * 64;
    { const int r = tid >> 3, c8 = (tid & 7) * 8; const float* src = W + (size_t)(k0 + r) * N + n0 + c8;
      const f32x4 a = *(const GASP f32x4*)src, b = *(const GASP f32x4*)(src + 4);
      LAS float* t = tile + r * 65 + c8; t[0] = a[0]; t[1] = a[1]; t[2] = a[2]; t[3] = a[3]; t[4] = b[0]; t[5] = b[1]; t[6] = b[2]; t[7] = b[3]; }
    __syncthreads();
    { const int n = tid >> 3, k8 = (tid & 7) * 8; const LAS float* t = tile + k8 * 65 + n;
      float w[8];
#pragma unroll
      for (int i = 0; i < 8; ++i) w[i] = t[i * 65];
      int nn = n0 + n; if (gu) nn = (nn < FF) ? ((nn >> 7) * 256 + (nn & 127)) : (((nn - FF) >> 7) * 256 + 128 + ((nn - FF) & 127));
      float s2 = 0.f;
      if (gam) {
#pragma unroll
          for (int i = 0; i < 8; ++i) { s2 += bet[k0 + k8 + i] * w[i]; w[i] *= gam[k0 + k8 + i]; }
      }
      u32x4 o; o.x = pk2(w[0], w[1]); o.y = pk2(w[2], w[3]); o.z = pk2(w[4], w[5]); o.w = pk2(w[6], w[7]);
      *(GASP u32x4*)(WT + (size_t)nn * K + k0 + k8) = o;
      if (gam) {
          float s1 = ((__uint_as_float(o.x << 16) + __uint_as_float(o.x & 0xffff0000u)) + (__uint_as_float(o.y << 16) + __uint_as_float(o.y & 0xffff0000u)))
                   + ((__uint_as_float(o.z << 16) + __uint_as_float(o.z & 0xffff0000u)) + (__uint_as_float(o.w << 16) + __uint_as_float(o.w & 0xffff0000u)));
          s1 += __shfl_xor(s1, 1); s1 += __shfl_xor(s1, 2); s1 += __shfl_xor(s1, 4);
          s2 += __shfl_xor(s2, 1); s2 += __shfl_xor(s2, 2); s2 += __shfl_xor(s2, 4);
          if ((tid & 7) == 0) { c1p[(size_t)kb * NC12 + nn] = s1; c2p[(size_t)kb * NC12 + nn] = s2; }
      } }
    __syncthreads();
}
__device__ __forceinline__ void cvt_rows(const float* src, bf16_t* dst, size_t n8, size_t gtid, size_t gn) {
    for (size_t i = gtid; i < n8; i += gn) { const f32x4 a = *(const GASP f32x4*)(src + 8 * i), b = *(const GASP f32x4*)(src + 8 * i + 4);
        u32x4 o; o.x = pk2(a[0], a[1]); o.y = pk2(a[2], a[3]); o.z = pk2(b[0], b[1]); o.w = pk2(b[2], b[3]); *(GASP u32x4*)(dst + 8 * i) = o; }
}
__device__ __forceinline__ void phase_prep(const Params& p, LAS unsigned char* lds) {
    unsigned char* ws = p.ws; const int G = gridDim.x, bx = blockIdx.x;
    if (bx == 0 && threadIdx.x < 64) ((unsigned*)(ws + O_CTR))[threadIdx.x] = 0u;
    LAS float* tile = (LAS float*)lds;
    constexpr int I_GU = 16 * 88, I_DN = 44 * 16, I_IN = 16 * 40, I_SQ = 16 * 16;
    constexpr int NIT = 2 * I_GU + 2 * I_DN + I_IN + 5 * I_SQ;
    for (int it = bx; it < NIT; it += G) {
        int r = it;
        if (r < I_GU) { transpose_item(p.in[7], D, 2 * FF, (bf16_t*)(ws + O_WGU1), r, 1, tile); continue; } r -= I_GU;
        if (r < I_GU) { transpose_item(p.in[30], D, 2 * FF, (bf16_t*)(ws + O_WGU2), r, 1, tile, p.in[28], p.in[29], (float*)(ws + O_C1P) + C_GU2, (float*)(ws + O_C2P) + C_GU2); continue; } r -= I_GU;
        if (r < I_DN) { transpose_item(p.in[8], FF, D, (bf16_t*)(ws + O_WDN1), r, 0, tile); continue; } r -= I_DN;
        if (r < I_DN) { transpose_item(p.in[31], FF, D, (bf16_t*)(ws + O_WDN2), r, 0, tile); continue; } r -= I_DN;
        if (r < I_IN) { transpose_item(p.in[11], D, INC, (bf16_t*)(ws + O_WIN), r, 0, tile, p.in[9], p.in[10], (float*)(ws + O_C1P) + C_IN, (float*)(ws + O_C2P) + C_IN); continue; } r -= I_IN;
        if (r < I_SQ) { transpose_item(p.in[21], D, D, (bf16_t*)(ws + O_WOUT), r, 0, tile); continue; } r -= I_SQ;
        if (r < I_SQ) { transpose_item(p.in[24], D, D, (bf16_t*)(ws + O_WQ), r, 0, tile, p.in[22], p.in[23], (float*)(ws + O_C1P) + C_Q, (float*)(ws + O_C2P) + C_Q); continue; } r -= I_SQ;
        if (r < I_SQ) { transpose_item(p.in[25], D, D, (bf16_t*)(ws + O_WKV), r, 0, tile); continue; } r -= I_SQ;
        if (r < I_SQ) { transpose_item(p.in[26], D, D, (bf16_t*)(ws + O_WKV) + (size_t)D * D, r, 0, tile); continue; } r -= I_SQ;
        transpose_item(p.in[27], D, D, (bf16_t*)(ws + O_WO), r, 0, tile);
    }
    const size_t gtid = (size_t)bx * 512 + threadIdx.x, gn = (size_t)G * 512;
    cvt_rows(p.in[0], (bf16_t*)(ws + O_XB), (size_t)NP * D / 8, gtid, gn);
    cvt_rows(p.in[1], (bf16_t*)(ws + O_XB) + (size_t)NP * D, (size_t)NS * D / 8, gtid, gn);
    cvt_rows(p.in[6], (bf16_t*)(ws + O_MEMB), (size_t)4096 * D / 8, gtid, gn);
    for (size_t i = gtid; i < 4 * 128 * 128 / 2; i += gn) { const int e = (int)i * 2, t = (e >> 7) & 127, s = e & 127;
        const float a = s <= t ? p.in[19][e] : 0.f, b = (s + 1) <= t ? p.in[19][e + 1] : 0.f; ((unsigned*)(ws + O_WSB))[i] = pk2(a, b); }
}

__device__ __forceinline__ void phase_ln(const bf16_t* src, float* dstf, bf16_t* dstb, const float* gam, const float* bet) {
    const int lane = threadIdx.x & 63, gw = blockIdx.x * 8 + (threadIdx.x >> 6), NGW = gridDim.x * 8;
    f32x4 gg[4], bb[4];
#pragma unroll
    for (int j = 0; j < 4; ++j) { gg[j] = ((const GASP f32x4*)gam)[64 * j + lane]; bb[j] = ((const GASP f32x4*)bet)[64 * j + lane]; }
    for (int row = gw; row < M; row += NGW) {
        const GASP u32x2* xr = (const GASP u32x2*)(src + (size_t)row * D) + lane;
        u32x2 raw[4];
#pragma unroll
        for (int j = 0; j < 4; ++j) raw[j] = xr[64 * j];
        f32x4 v[4]; float s = 0.f;
#pragma unroll
        for (int j = 0; j < 4; ++j) { v[j] = (f32x4){__uint_as_float(raw[j].x << 16), __uint_as_float(raw[j].x & 0xffff0000u), __uint_as_float(raw[j].y << 16), __uint_as_float(raw[j].y & 0xffff0000u)};
            s += (v[j][0] + v[j][1]) + (v[j][2] + v[j][3]); }
        const float mean = wave_sum(s) * (1.f / D); float s2 = 0.f;
#pragma unroll
        for (int j = 0; j < 4; ++j) { v[j] = v[j] - mean; s2 += (v[j][0] * v[j][0] + v[j][1] * v[j][1]) + (v[j][2] * v[j][2] + v[j][3] * v[j][3]); }
        const float rstd = 1.f / sqrtf(wave_sum(s2) * (1.f / D) + LN_EPS);
#pragma unroll
        for (int j = 0; j < 4; ++j) {
            const f32x4 y = v[j] * rstd * gg[j] + bb[j];
            ((GASP f32x4*)(dstf + (size_t)row * D))[64 * j + lane] = y;
            if (dstb) { u32x2 w; w.x = pk2(y[0], y[1]); w.y = pk2(y[2], y[3]); ((GASP u32x2*)(dstb + (size_t)row * D))[64 * j + lane] = w; }
        }
    }
}

__device__ __forceinline__ s16x4 vtr(const LAS unsigned char* p) { return __builtin_bit_cast(s16x4, __builtin_amdgcn_ds_read_tr16_b64_v4i16((LAS v4i16_t*)p)); }
__device__ __forceinline__ bf16x8 cat8(s16x4 lo, s16x4 hi) { return (bf16x8){lo[0], lo[1], lo[2], lo[3], hi[0], hi[1], hi[2], hi[3]}; }
__device__ __forceinline__ bf16x8 packp(const f32x16& x, int b) {
    u32x4 w; w.x = pk2(x[b], x[b + 1]); w.y = pk2(x[b + 2], x[b + 3]); w.z = pk2(x[b + 4], x[b + 5]); w.w = pk2(x[b + 6], x[b + 7]); return __builtin_bit_cast(bf16x8, w);
}
__device__ __forceinline__ u32x4 cvt8(u32x4 a, u32x4 b) {
    u32x4 o; o.x = pk2(__uint_as_float(a.x), __uint_as_float(a.y)); o.y = pk2(__uint_as_float(a.z), __uint_as_float(a.w));
    o.z = pk2(__uint_as_float(b.x), __uint_as_float(b.y)); o.w = pk2(__uint_as_float(b.z), __uint_as_float(b.w)); return o;
}
template <int NEB>
__device__ __forceinline__ void softmax_tile(f32x16& X0, f32x16& X1, float& m, float& l, f32x16 (&OT)[NEB]) {
    float mx = X0[0];
#pragma unroll
    for (int r = 1; r < 16; ++r) mx = fmaxf(mx, X0[r]);
#pragma unroll
    for (int r = 0; r < 16; ++r) mx = fmaxf(mx, X1[r]);
    mx = fmaxf(mx, __shfl_xor(mx, 32));
    if (__any(mx > m + 8.f)) {
        const float mn = fmaxf(m, mx), alpha = fexp2(m - mn); m = mn; l *= alpha;
#pragma unroll
        for (int e = 0; e < NEB; ++e) OT[e] = OT[e] * alpha;
    }
    float s = 0.f;
#pragma unroll
    for (int r = 0; r < 16; ++r) { X0[r] = fexp2(X0[r] - m); X1[r] = fexp2(X1[r] - m); s += X0[r] + X1[r]; }
    l += s;
}
template <int VRS, int NEB, bool SB = false>
__device__ __forceinline__ void pv_tile(f32x16 (&OT)[NEB], const f32x16& X0, const f32x16& X1, const LAS unsigned char* vlane  ) {
#pragma unroll
    for (int kk = 0; kk < 4; ++kk) {
        const bf16x8 pa = packp(kk < 2 ? X0 : X1, (kk & 1) * 8);
#pragma unroll
        for (int eb = 0; eb < NEB; ++eb) {
            const s16x4 lo = vtr(vlane + (kk * 16) * VRS + eb * 64), hi = vtr(vlane + (kk * 16 + 8) * VRS + eb * 64);
            OT[eb] = __builtin_amdgcn_mfma_f32_32x32x16_bf16(cat8(lo, hi), pa, OT[eb], 0, 0, 0);
        }
        if (SB) __builtin_amdgcn_sched_barrier(0);
    }
}

constexpr int DA_KRS = 144, DA_VRS = 320, DA_KMAP = 64 * DA_KRS, DA_VOFF = 2 * DA_KMAP, DA_BUF = DA_VOFF + 64 * DA_VRS;
template <bool SAMPLE, int EXPER = 0>
__device__ __forceinline__ void diff_unit(const Params& p, LAS unsigned char* L, int b, int h, int qi, float lam) {
    unsigned char* ws = p.ws;
    int tid = threadIdx.x; asm volatile("" : "+v"(tid));
    const int lane = tid & 63, r = lane & 31, hi = lane >> 5, wid = __builtin_amdgcn_readfirstlane(tid >> 6), map = wid >> 2, sub = wid & 3;
    const bf16_t* QB = (const bf16_t*)(ws + O_QB); const bf16_t* KB = (const bf16_t*)(ws + O_KB); const bf16_t* VB = (const bf16_t*)(ws + O_VB);
    constexpr int NEB = 4, NPF = SAMPLE ? 8 : 4;
    const int S = SAMPLE ? PAST + DECS : SEQ, qpos0 = SAMPLE ? PAST : qi * 128 + sub * 32, rowq0 = SAMPLE ? NP + b * 32 : b * SEQ + qi * 128 + sub * 32;
    const int NT = SAMPLE ? (PAST + DECS + 63) / 64 : 2 * qi + 2;
    const int ntw = SAMPLE ? NT : min(NT, (qpos0 >> 6) + 1);
    const float slope2 = exp2f(-2.f * (float)(h + 1)) * LOG2E;
    bf16x8 qf[4];
    { const bf16_t* qp = QB + (size_t)(rowq0 + r) * 512 + h * 128 + map * 64 + hi * 8;
#pragma unroll
      for (int d0 = 0; d0 < 4; ++d0) qf[d0] = *(const GASP bf16x8*)(qp + d0 * 16); }
    f32x16 OT[NEB];
#pragma unroll
    for (int e = 0; e < NEB; ++e)
#pragma unroll
        for (int i = 0; i < 16; ++i) OT[e][i] = 0.f;
    float m = -1e30f, l = 0.f;
    const int lkey = tid >> 3, lc = tid & 7;
    u32x4 pfA[NPF], pfB[SAMPLE ? 1 : NPF];
    const float* ck = p.in[2]; const float* cv = p.in[3];
#define DA_ISSUE(pf, tt) do { const int s_ = (tt) * 64 + lkey; \
        if (SAMPLE && (tt) < PAST / 64) { const size_t o_ = ((size_t)(b * PAST + s_) * 512 + h * 128 + lc * 16); \
            _Pragma("unroll") for (int i_ = 0; i_ < 4; ++i_) { pf[i_] = *(const GASP u32x4*)(ck + o_ + 4 * i_); pf[NPF - 4 + i_] = *(const GASP u32x4*)(cv + o_ + 4 * i_); } } \
        else { const int row_ = SAMPLE ? NP + b * 32 + min(s_ - PAST, DECS - 1) : b * SEQ + s_; const size_t o_ = (size_t)row_ * 512 + h * 128 + lc * 16; \
            pf[0] = *(const GASP u32x4*)(KB + o_); pf[1] = *(const GASP u32x4*)(KB + o_ + 8); pf[2] = *(const GASP u32x4*)(VB + o_); pf[3] = *(const GASP u32x4*)(VB + o_ + 8); } } while (0)
#define DA_WRITE(pf, tt, buf) do { u32x4 k0_, k1_, v0_, v1_; \
        if (SAMPLE && (tt) < PAST / 64) { k0_ = cvt8(pf[0], pf[1]); k1_ = cvt8(pf[2], pf[3]); v0_ = cvt8(pf[NPF - 4], pf[NPF - 3]); v1_ = cvt8(pf[NPF - 2], pf[NPF - 1]); } \
        else { k0_ = pf[0]; k1_ = pf[1]; v0_ = pf[2]; v1_ = pf[3]; } \
        LAS unsigned char* kd_ = L + (buf) * DA_BUF + (lc >> 2) * DA_KMAP + lkey * DA_KRS + (lc & 3) * 32; \
        LAS unsigned char* vd_ = L + (buf) * DA_BUF + DA_VOFF + lkey * DA_VRS + lc * 32; \
        *(LAS u32x4*)kd_ = k0_; *(LAS u32x4*)(kd_ + 16) = k1_; *(LAS u32x4*)vd_ = v0_; *(LAS u32x4*)(vd_ + 16) = v1_; } while (0)
    const int i16 = lane & 15;
    const int vlane_off = (4 * hi + (i16 >> 2)) * DA_VRS + (16 * ((lane >> 4) & 1) + 4 * (i16 & 3)) * 2;
    const int tq = qpos0 + r;
#define DA_COMPUTE(tt, buf) do { if ((tt) < ntw && (!SAMPLE || (((tt) & 3) == sub))) { \
            const LAS unsigned char* Kb = L + (buf) * DA_BUF + map * DA_KMAP + r * DA_KRS + hi * 16; \
            f32x16 X0, X1; \
            _Pragma("unroll") for (int i = 0; i < 16; ++i) { X0[i] = 0.f; X1[i] = 0.f; } \
            _Pragma("unroll") for (int d0 = 0; d0 < 4; ++d0) { \
                const bf16x8 k0 = *(const LAS bf16x8*)(Kb + d0 * 32), k1 = *(const LAS bf16x8*)(Kb + 32 * DA_KRS + d0 * 32); \
                X0 = __builtin_amdgcn_mfma_f32_32x32x16_bf16(k0, qf[d0], X0, 0, 0, 0); \
                X1 = __builtin_amdgcn_mfma_f32_32x32x16_bf16(k1, qf[d0], X1, 0, 0, 0); } \
            const float dd0 = (float)(tq - ((tt) * 64 + 4 * hi)); \
            _Pragma("unroll") for (int rg = 0; rg < 16; ++rg) { const float c = (float)((rg & 3) + 8 * (rg >> 2)); \
                X0[rg] = X0[rg] - slope2 * fabsf(dd0 - c); X1[rg] = X1[rg] - slope2 * fabsf(dd0 - 32.f - c); } \
            if ((tt) * 64 + 32 >= S) { _Pragma("unroll") for (int rg = 0; rg < 16; ++rg) X1[rg] = -1e30f; } \
            if (!(EXPER & 2)) softmax_tile<NEB>(X0, X1, m, l, OT); else l += X0[0]; \
            if (!(EXPER & 1)) pv_tile<DA_VRS, NEB, SAMPLE>(OT, X0, X1, L + (buf) * DA_BUF + DA_VOFF + vlane_off); else OT[0] = OT[0] + X0 + X1; } } while (0)
    DA_ISSUE(pfA, 0); DA_WRITE(pfA, 0, 0);
    if constexpr (SAMPLE) {
        asm volatile("" : "+v"(qf[0]), "+v"(qf[1]), "+v"(qf[2]), "+v"(qf[3]));
        __syncthreads();
#pragma unroll 1
        for (int tt = 0; tt < NT; ++tt) {
            if (tt + 1 < NT) DA_ISSUE(pfA, tt + 1);
            DA_COMPUTE(tt, tt & 1);
            if (tt + 1 < NT) DA_WRITE(pfA, tt + 1, (tt + 1) & 1);
            __syncthreads();
        }
    } else {
    if (NT > 1) DA_ISSUE(pfA, 1);
    asm volatile("" : "+v"(qf[0]), "+v"(qf[1]), "+v"(qf[2]), "+v"(qf[3]));
    __syncthreads();
    for (int tt = 0; tt < NT; tt += 2) {
        if (tt + 2 < NT) DA_ISSUE(pfB, tt + 2);
        DA_COMPUTE(tt, 0);
        if (tt + 1 < NT) DA_WRITE(pfA, tt + 1, 1);
        __syncthreads();
        if (tt + 1 >= NT) break;
        if (tt + 3 < NT) DA_ISSUE(pfA, tt + 3);
        DA_COMPUTE(tt + 1, 1);
        if (tt + 2 < NT) DA_WRITE(pfB, tt + 2, 0);
        __syncthreads();
    }
    }
#undef DA_COMPUTE
#undef DA_ISSUE
#undef DA_WRITE
    l += __shfl_xor(l, 32);
    if constexpr (SAMPLE) {
        LAS float* SLB = (LAS float*)L; LAS f32x2* ML = (LAS f32x2*)(L + 131072); LAS float* SS = (LAS float*)(L + 131072 + 2048);
        if (hi == 0) ML[(map * 4 + sub) * 32 + r] = (f32x2){m, l};
        __syncthreads();
        float M = -1e30f;
#pragma unroll
        for (int s4 = 0; s4 < 4; ++s4) M = fmaxf(M, ML[(map * 4 + s4) * 32 + r][0]);
        float Lsum = 0.f;
#pragma unroll
        for (int s4 = 0; s4 < 4; ++s4) { const f32x2 v = ML[(map * 4 + s4) * 32 + r]; Lsum += v[1] * fexp2(v[0] - M); }
        const float f = fexp2(m - M) * frcp(Lsum);
        LAS float* mine = SLB + (map * 4 + sub) * 4096;
#pragma unroll
        for (int eb = 0; eb < 4; ++eb)
#pragma unroll
            for (int rg = 0; rg < 16; ++rg) mine[(eb * 32 + (rg & 3) + 8 * (rg >> 2) + 4 * hi) * 32 + r] = OT[eb][rg] * f;
        __syncthreads();
        float o16[16]; float ss = 0.f;
        if (map == 0) {
#pragma unroll
            for (int rg = 0; rg < 16; ++rg) { const int idx = (sub * 32 + (rg & 3) + 8 * (rg >> 2) + 4 * hi) * 32 + r;
                const float o1 = (SLB[idx] + SLB[4096 + idx]) + (SLB[2 * 4096 + idx] + SLB[3 * 4096 + idx]);
                const float o2 = (SLB[4 * 4096 + idx] + SLB[5 * 4096 + idx]) + (SLB[6 * 4096 + idx] + SLB[7 * 4096 + idx]);
                const float o = o1 - lam * o2; o16[rg] = o; ss += o * o; }
            ss += __shfl_xor(ss, 32);
            if (hi == 0) SS[sub * 32 + r] = ss;
        }
        __syncthreads();
        if (map == 0) {
            ss = (SS[r] + SS[32 + r]) + (SS[64 + r] + SS[96 + r]);
            const float rms = 0.8f / sqrtf(ss * (1.f / 128.f) + LN_EPS);
            const float* sg = p.in[16];
            bf16_t* op = (bf16_t*)(ws + O_MIX) + (size_t)(rowq0 + r) * D + h * 128 + sub * 32 + 4 * hi;
#pragma unroll
            for (int g4 = 0; g4 < 4; ++g4) { const f32x4 gv = *(const GASP f32x4*)(sg + sub * 32 + 8 * g4 + 4 * hi);
                u32x2 w; w.x = pk2(o16[4 * g4] * rms * gv[0], o16[4 * g4 + 1] * rms * gv[1]); w.y = pk2(o16[4 * g4 + 2] * rms * gv[2], o16[4 * g4 + 3] * rms * gv[3]);
                *(GASP u32x2*)(op + 8 * g4) = w; }
        }
        __syncthreads();
    } else {
        const float inv = frcp(l);
        LAS float* X = (LAS float*)L + sub * 4096;
        if (map == 1) {
#pragma unroll
            for (int eb = 0; eb < 4; ++eb)
#pragma unroll
                for (int rg = 0; rg < 16; ++rg) X[(eb * 32 + (rg & 3) + 8 * (rg >> 2) + 4 * hi) * 32 + r] = OT[eb][rg] * inv;
        }
        __syncthreads();
        if (map == 0) {
            float ss = 0.f;
#pragma unroll
            for (int eb = 0; eb < 4; ++eb)
#pragma unroll
                for (int rg = 0; rg < 16; ++rg) { const float o = OT[eb][rg] * inv - lam * X[(eb * 32 + (rg & 3) + 8 * (rg >> 2) + 4 * hi) * 32 + r]; OT[eb][rg] = o; ss += o * o; }
            ss += __shfl_xor(ss, 32);
            const float rms = 0.8f / sqrtf(ss * (1.f / 128.f) + LN_EPS);
            const float* sg = p.in[16];
            bf16_t* op = (bf16_t*)(ws + O_MIX) + (size_t)(rowq0 + r) * D + h * 128 + 4 * hi;
#pragma unroll
            for (int eb = 0; eb < 4; ++eb)
#pragma unroll
                for (int g4 = 0; g4 < 4; ++g4) { const int e0 = eb * 32 + 8 * g4; const f32x4 gv = *(const GASP f32x4*)(sg + e0 + 4 * hi);
                    u32x2 w; w.x = pk2(OT[eb][4 * g4] * rms * gv[0], OT[eb][4 * g4 + 1] * rms * gv[1]); w.y = pk2(OT[eb][4 * g4 + 2] * rms * gv[2], OT[eb][4 * g4 + 3] * rms * gv[3]);
                    *(GASP u32x2*)(op + e0) = w; }
        }
        __syncthreads();
    }
}

__device__ __forceinline__ void gate_unit(const Params& p, LAS unsigned char* L, int row0, int n, int g, int sample_b) {
    unsigned char* ws = p.ws;
    int tid = threadIdx.x; asm volatile("" : "+v"(tid));
    const int lane = tid & 63, r = lane & 31, hi = lane >> 5, wid = __builtin_amdgcn_readfirstlane(tid >> 6);
    const bf16_t* GVF = (const bf16_t*)(ws + O_GVF); const float* GST = (const float*)(ws + O_GST); const bf16_t* UB = (const bf16_t*)(ws + O_UB); const bf16_t* WSB = (const bf16_t*)(ws + O_WSB);
    const float* lng = p.in[17]; const float* lnb = p.in[18]; const float* bs = p.in[20];
    const int tb = wid & 3, dh = wid >> 2;
    const bool active = tb * 32 < n;
    const int nks = active ? min((tb + 1) * 2, n / 16) : 0;
    const int t = tid >> 2, ch = tid & 3; const bool ldr = t < n;
    f32x4 xv[8], sp[4];
    if (ldr) { const bf16_t* src = GVF + (size_t)(row0 + t) * 512 + g * 128 + ch * 32; const GASP f32x4* sq = (const GASP f32x4*)(GST + (size_t)(row0 + t) * 16);
        u32x4 rawv[4];
#pragma unroll
        for (int i = 0; i < 4; ++i) rawv[i] = *(const GASP u32x4*)(src + 8 * i);
#pragma unroll
        for (int i = 0; i < 4; ++i) { xv[2 * i] = (f32x4){__uint_as_float(rawv[i].x << 16), __uint_as_float(rawv[i].x & 0xffff0000u), __uint_as_float(rawv[i].y << 16), __uint_as_float(rawv[i].y & 0xffff0000u)};
            xv[2 * i + 1] = (f32x4){__uint_as_float(rawv[i].z << 16), __uint_as_float(rawv[i].z & 0xffff0000u), __uint_as_float(rawv[i].w << 16), __uint_as_float(rawv[i].w & 0xffff0000u)}; }
#pragma unroll
        for (int i = 0; i < 4; ++i) sp[i] = sq[i]; }
    bf16x8 wf[8];
    { const bf16_t* wp = WSB + (size_t)(g * 128 + tb * 32 + r) * 128 + 8 * hi;
#pragma unroll
      for (int ks = 0; ks < 8; ++ks) if (ks < nks) wf[ks] = *(const GASP bf16x8*)(wp + ks * 16); }
    const int te = tb * 32 + r;
    u32x2 uu[8]; float bias = 0.f;
    if (active) { const bf16_t* up = UB + (size_t)(row0 + te) * 512 + g * 128 + dh * 64 + 4 * hi; bias = bs[g * 128 + te];
#pragma unroll
        for (int i = 0; i < 8; ++i) uu[i] = *(const GASP u32x2*)(up + (i >> 2) * 32 + 8 * (i & 3)); }
    if (ldr) {
        float s = 0.f, q = 0.f;
#pragma unroll
        for (int i = 0; i < 4; ++i) { s += sp[i][0] + sp[i][2]; q += sp[i][1] + sp[i][3]; }
        const float mean = s * (1.f / 512.f), rstd = 1.f / sqrtf(q * (1.f / 512.f) - mean * mean + LN_EPS);
        const float* gp = lng + g * 128 + ch * 32; const float* bp = lnb + g * 128 + ch * 32;
#pragma unroll
        for (int i = 0; i < 4; ++i) {
            const f32x4 ya = (xv[2 * i] - mean) * rstd * *(const GASP f32x4*)(gp + 8 * i) + *(const GASP f32x4*)(bp + 8 * i);
            const f32x4 yc = (xv[2 * i + 1] - mean) * rstd * *(const GASP f32x4*)(gp + 8 * i + 4) + *(const GASP f32x4*)(bp + 8 * i + 4);
            u32x4 w; w.x = pk2(ya[0], ya[1]); w.y = pk2(ya[2], ya[3]); w.z = pk2(yc[0], yc[1]); w.w = pk2(yc[2], yc[3]);
            *(LAS u32x4*)(L + t * DA_VRS + ch * 64 + i * 16) = w;
            if (sample_b >= 0) { float* o = p.out + OUT_GV + (size_t)(sample_b * 32 + t) * 512 + g * 128 + ch * 32 + 8 * i; *(GASP f32x4*)o = ya; *(GASP f32x4*)(o + 4) = yc; }
        }
    }
    __syncthreads();
    if (active) {
        const int i16 = lane & 15;
        const int vlane_off = (8 * hi + (i16 >> 2)) * DA_VRS + (16 * ((lane >> 4) & 1) + 4 * (i16 & 3)) * 2 + dh * 128;
        f32x16 OT[2];
#pragma unroll
        for (int e = 0; e < 2; ++e)
#pragma unroll
            for (int i = 0; i < 16; ++i) OT[e][i] = 0.f;
#pragma unroll
        for (int ks = 0; ks < 8; ++ks) if (ks < nks) {
#pragma unroll
            for (int db = 0; db < 2; ++db) {
                const s16x4 lo = vtr(L + vlane_off + (ks * 16) * DA_VRS + db * 64), hi4 = vtr(L + vlane_off + (ks * 16 + 4) * DA_VRS + db * 64);
                OT[db] = __builtin_amdgcn_mfma_f32_32x32x16_bf16(cat8(lo, hi4), wf[ks], OT[db], 0, 0, 0);
            }
        }
        bf16_t* op = (bf16_t*)(ws + O_MIX) + (size_t)(row0 + te) * D + 512 + g * 128 + dh * 64 + 4 * hi;
#pragma unroll
        for (int db = 0; db < 2; ++db)
#pragma unroll
            for (int g4 = 0; g4 < 4; ++g4) { const u32x2 u2 = uu[db * 4 + g4];
                const float u0 = __uint_as_float(u2.x << 16), u1 = __uint_as_float(u2.x & 0xffff0000u), u2f = __uint_as_float(u2.y << 16), u3 = __uint_as_float(u2.y & 0xffff0000u);
                u32x2 w; w.x = pk2(u0 * (OT[db][4 * g4] + bias), u1 * (OT[db][4 * g4 + 1] + bias)); w.y = pk2(u2f * (OT[db][4 * g4 + 2] + bias), u3 * (OT[db][4 * g4 + 3] + bias));
                *(GASP u32x2*)(op + db * 32 + 8 * g4) = w; }
    }
    __syncthreads();
}

constexpr int CA_KRS = 528, CA_VRS = 576, CA_VOFF = 64 * CA_KRS, CA_BUF = CA_VOFF + 64 * CA_VRS;
__device__ __forceinline__ void cross_unit(const Params& p, LAS unsigned char* L, int bb, int h, int qi) {
    unsigned char* ws = p.ws;
    int tid = threadIdx.x; asm volatile("" : "+v"(tid));
    const int lane = tid & 63, r = lane & 31, hi = lane >> 5, wid = __builtin_amdgcn_readfirstlane(tid >> 6), sub = wid & 3, dh = wid >> 2;
    const bf16_t* QC = (const bf16_t*)(ws + O_QC); const bf16_t* MKB = (const bf16_t*)(ws + O_MKB); const bf16_t* MVB = (const bf16_t*)(ws + O_MVB);
    const int nq = bb < 16 ? 128 : 32, rowq0 = bb < 16 ? bb * SEQ + qi * 128 : NP + (bb - 16) * 32;
    const bool active = sub * 32 < nq;
    const bf16_t* qp = QC + (size_t)(rowq0 + (active ? sub * 32 : 0) + r) * D + h * 256 + hi * 8;
    bf16x8 qf[16];
#pragma unroll
    for (int d0 = 0; d0 < 16; ++d0) qf[d0] = *(const GASP bf16x8*)(qp + d0 * 16);
    f32x16 OT[4];
#pragma unroll
    for (int e = 0; e < 4; ++e)
#pragma unroll
        for (int i = 0; i < 16; ++i) OT[e][i] = 0.f;
    float m = -1e30f, l = 0.f;
    const int lrow = tid >> 3, lc = tid & 7;
    u32x4 pf[8];
#define CA_ISSUE(tt) do { const size_t o_ = (size_t)(bb * 256 + (tt) * 64 + lrow) * D + h * 256 + lc * 32; \
        _Pragma("unroll") for (int i_ = 0; i_ < 4; ++i_) { pf[i_] = *(const GASP u32x4*)(MKB + o_ + 8 * i_); pf[4 + i_] = *(const GASP u32x4*)(MVB + o_ + 8 * i_); } } while (0)
#define CA_WRITE(buf) do { LAS unsigned char* kd_ = L + (buf) * CA_BUF + lrow * CA_KRS + lc * 64; LAS unsigned char* vd_ = L + (buf) * CA_BUF + CA_VOFF + lrow * CA_VRS + lc * 64; \
        _Pragma("unroll") for (int i_ = 0; i_ < 4; ++i_) { *(LAS u32x4*)(kd_ + 16 * i_) = pf[i_]; *(LAS u32x4*)(vd_ + 16 * i_) = pf[4 + i_]; } } while (0)
    CA_ISSUE(0); CA_WRITE(0);
#pragma unroll
    for (int d0 = 0; d0 < 16; ++d0) asm volatile("" : "+v"(qf[d0]));
    __syncthreads();
    const int i16 = lane & 15;
    const int vlane_off = (4 * hi + (i16 >> 2)) * CA_VRS + (16 * ((lane >> 4) & 1) + 4 * (i16 & 3)) * 2 + dh * 256;
#pragma unroll 1
    for (int tt = 0; tt < 4; ++tt) {
        const int buf = tt & 1;
        if (tt + 1 < 4) CA_ISSUE(tt + 1);
        if (active) {
            const LAS unsigned char* Kb = L + buf * CA_BUF + r * CA_KRS + hi * 16;
            f32x16 X0, X1;
#pragma unroll
            for (int i = 0; i < 16; ++i) { X0[i] = 0.f; X1[i] = 0.f; }
#pragma unroll
            for (int d0 = 0; d0 < 16; ++d0) {
                const bf16x8 k0 = *(const LAS bf16x8*)(Kb + d0 * 32), k1 = *(const LAS bf16x8*)(Kb + 32 * CA_KRS + d0 * 32);
                X0 = __builtin_amdgcn_mfma_f32_32x32x16_bf16(k0, qf[d0], X0, 0, 0, 0);
                X1 = __builtin_amdgcn_mfma_f32_32x32x16_bf16(k1, qf[d0], X1, 0, 0, 0);
            }
            softmax_tile<4>(X0, X1, m, l, OT);
            pv_tile<CA_VRS, 4>(OT, X0, X1, L + buf * CA_BUF + CA_VOFF + vlane_off);
        }
        if (tt + 1 < 4) CA_WRITE(buf ^ 1);
        __syncthreads();
    }
#undef CA_ISSUE
#undef CA_WRITE
    if (active) {
        l += __shfl_xor(l, 32);
        const float inv = frcp(l);
        bf16_t* op = (bf16_t*)(ws + O_OC) + (size_t)(rowq0 + sub * 32 + r) * D + h * 256 + dh * 128 + 4 * hi;
#pragma unroll
        for (int eb = 0; eb < 4; ++eb)
#pragma unroll
            for (int g4 = 0; g4 < 4; ++g4) { u32x2 w; w.x = pk2(OT[eb][4 * g4] * inv, OT[eb][4 * g4 + 1] * inv); w.y = pk2(OT[eb][4 * g4 + 2] * inv, OT[eb][4 * g4 + 3] * inv);
                *(GASP u32x2*)(op + eb * 32 + 8 * g4) = w; }
    }
}

template <int MODE>
__device__ __forceinline__ void sample_reduce(const float* slab, int S, const float* res, float* out, float scale, const float* STp, const float* gam, const float* bet,
                                              bf16_t* ob, float* STn, const float* c1, const float* c2, const bf16_t* resb = nullptr) {
    const int lane = threadIdx.x & 63, gw = blockIdx.x * 8 + (threadIdx.x >> 6);
    if (gw >= NS) return;
    const int row = NP + gw;
    f32x4 acc[4];
#pragma unroll
    for (int j = 0; j < 4; ++j) acc[j] = (f32x4){0.f, 0.f, 0.f, 0.f};
    for (int ks = 0; ks < S; ++ks) { const GASP f32x4* sp = (const GASP f32x4*)(slab + ((size_t)ks * NS + gw) * D) + lane;
#pragma unroll
        for (int j = 0; j < 4; ++j) acc[j] = acc[j] + sp[64 * j]; }
    float mu = 0.f, rstd = 1.f;
    if (STp) { const GASP f32x4* sp = (const GASP f32x4*)(STp + (size_t)row * 32); float s = 0.f, q = 0.f;
#pragma unroll
        for (int i = 0; i < 8; ++i) { const f32x4 v = sp[i]; s += v[0] + v[2]; q += v[1] + v[3]; }
        mu = s * (1.f / D); rstd = 1.f / sqrtf(q * (1.f / D) - mu * mu + LN_EPS); }
    if (MODE == 0) {
        const GASP f32x4* rp = (const GASP f32x4*)(res + (size_t)row * D) + lane;
        float s = 0.f, q = 0.f;
#pragma unroll
        for (int j = 0; j < 4; ++j) { f32x4 r;
            if (resb) { const u32x2 w = ((const GASP u32x2*)(resb + (size_t)row * D))[64 * j + lane];
                r = (f32x4){__uint_as_float(w.x << 16), __uint_as_float(w.x & 0xffff0000u), __uint_as_float(w.y << 16), __uint_as_float(w.y & 0xffff0000u)}; }
            else r = rp[64 * j];
            if (STp) r = (r - mu) * rstd * ((const GASP f32x4*)gam)[64 * j + lane] + ((const GASP f32x4*)bet)[64 * j + lane];
            const f32x4 o = r * ALPHA + acc[j] * scale;
            if (out) ((GASP f32x4*)(out + (size_t)row * D))[64 * j + lane] = o;
            if (ob) { u32x2 w; w.x = pk2(o[0], o[1]); w.y = pk2(o[2], o[3]); ((GASP u32x2*)(ob + (size_t)row * D))[64 * j + lane] = w; }
            s += (o[0] + o[1]) + (o[2] + o[3]); q += (o[0] * o[0] + o[1] * o[1]) + (o[2] * o[2] + o[3] * o[3]); }
        if (STn) { s = wave_sum(s); q = wave_sum(q);
            if (lane < 16) *(GASP f32x2*)(STn + (size_t)row * 32 + 2 * lane) = lane == 0 ? (f32x2){s, q} : (f32x2){0.f, 0.f}; }
    } else {
#pragma unroll
        for (int j = 0; j < 4; ++j) { const f32x4 y = ((acc[j] - ((const GASP f32x4*)c1)[64 * j + lane] * mu) * rstd + ((const GASP f32x4*)c2)[64 * j + lane]) * scale;
            u32x2 w; w.x = pk2(y[0], y[1]); w.y = pk2(y[2], y[3]); ((GASP u32x2*)(ob + (size_t)row * D))[64 * j + lane] = w; }
    }
}

__device__ __forceinline__ int queue_next(unsigned* ctr, LAS unsigned char* lds) {
    volatile LAS unsigned* w = (volatile LAS unsigned*)(lds + LDS_CTL);
    if (threadIdx.x == 0) w[0] = atomicAdd(ctr, 1u);
    __syncthreads();
    const int u = (int)w[0];
    __syncthreads();
    return u;
}

__device__ __forceinline__ int queue_pass(unsigned nxt, LAS unsigned char* lds) {
    volatile LAS unsigned* w = (volatile LAS unsigned*)(lds + LDS_CTL);
    if (threadIdx.x == 0) w[0] = nxt;
    __syncthreads();
    const int u = (int)w[0];
    __syncthreads();
    return u;
}

#define XB_TMO      128
#define XB_XCNT(j)  (256  + 64 * (j))
#define XB_XSUB(j)  (1280 + 64 * (j))
#define XB_XGEN(j)  (2304 + 64 * (j))
#define XB_TOP      3328
#define XB_TOPGEN   3392
#define XCD_BAR_WORDS 3456
#define XB_SPIN_CAP (1u << 18)
__device__ __forceinline__ unsigned xb_ld(unsigned* p)              { return __hip_atomic_load(p, __ATOMIC_RELAXED, __HIP_MEMORY_SCOPE_AGENT); }
__device__ __forceinline__ unsigned xb_add(unsigned* p, unsigned v) { return __hip_atomic_fetch_add(p, v, __ATOMIC_RELAXED, __HIP_MEMORY_SCOPE_AGENT); }
__device__ __forceinline__ unsigned xb_xcc_id() { return (unsigned)__builtin_amdgcn_s_getreg((3 << 11) | 20) & 0xFu; }
#define XB_SPIN(cond, bar) do { unsigned _sp = 0; while (cond) { __builtin_amdgcn_s_sleep(1); \
    if ((++_sp & 255u) == 0u) { if (xb_ld(&(bar)[XB_TMO])) break; if (_sp > XB_SPIN_CAP) { atomicAdd(&(bar)[XB_TMO], 1u); break; } } } } while (0)
struct XcdBarrier { unsigned* bar; unsigned x; volatile LAS unsigned* st; };
__device__ __forceinline__ XcdBarrier xcd_barrier_post(unsigned* bar, volatile LAS unsigned* st) {
    XcdBarrier b; b.bar = bar; b.x = xb_xcc_id(); b.st = st;
    if (threadIdx.x == 0) (void)xb_add(&bar[XB_XCNT(b.x)], 1u);
    return b;
}
__device__ __forceinline__ void xcd_barrier_complete(unsigned* bar, unsigned x, unsigned& nloc, unsigned& nx) {
    const unsigned G = gridDim.x * gridDim.y * gridDim.z;
    unsigned sum, cnt, mine, sp = 0u;
    for (;;) {
        sum = 0u; cnt = 0u; mine = 0u;
#pragma unroll
        for (unsigned j = 0; j < 16; ++j) { const unsigned c = xb_ld(&bar[XB_XCNT(j)]); sum += c; cnt += (c > 0u) ? 1u : 0u; mine = (j == x) ? c : mine; }
        if (sum == G) break;
        __builtin_amdgcn_s_sleep(1);
        if ((++sp & 255u) == 0u) { if (xb_ld(&bar[XB_TMO])) break; if (sp > XB_SPIN_CAP) { atomicAdd(&bar[XB_TMO], 1u); break; } }
    }
    nloc = mine > 0u ? mine : 1u; nx = cnt > 0u ? cnt : 1u;
}
__device__ __forceinline__ void xcd_barrier(const XcdBarrier& b) {
    asm volatile("s_waitcnt vmcnt(0)" ::: "memory");
    __syncthreads();
    if (threadIdx.x == 0) {
        unsigned* bar = b.bar;
        __builtin_amdgcn_s_waitcnt(0);
        unsigned nloc = b.st[0], nx = b.st[1];
        if (nloc == 0u) { xcd_barrier_complete(bar, b.x, nloc, nx); b.st[0] = nloc; b.st[1] = nx; }
        const unsigned old = xb_add(&bar[XB_XSUB(b.x)], 1u);
        const unsigned gen = old / nloc;
        if (old + 1u == (gen + 1u) * nloc) {
            __builtin_amdgcn_fence(__ATOMIC_RELEASE, "agent");
            asm volatile("s_waitcnt vmcnt(0)" ::: "memory");
            const unsigned og = xb_add(&bar[XB_TOP], 1u);
            const unsigned tg = og / nx;
            if (og + 1u == (tg + 1u) * nx) xb_add(&bar[XB_TOPGEN], 1u);
            else XB_SPIN(xb_ld(&bar[XB_TOPGEN]) == tg, bar);
            __builtin_amdgcn_fence(__ATOMIC_ACQUIRE, "agent");
            xb_add(&bar[XB_XGEN(b.x)], 1u);
            asm volatile("s_waitcnt vmcnt(0)" ::: "memory");
        } else {
            XB_SPIN(xb_ld(&bar[XB_XGEN(b.x)]) == gen, bar);
            __builtin_amdgcn_fence(__ATOMIC_ACQUIRE, "agent");
            asm volatile("s_waitcnt vmcnt(0)" ::: "memory");
        }
    }
    __syncthreads();
}

__global__ void __launch_bounds__(512, 2) mega(Params p) {
#if defined(__HIP_DEVICE_COMPILE__)
#pragma unroll
    for (int i = 0; i < 34; ++i) { __builtin_assume(!__builtin_amdgcn_is_shared((const void*)p.in[i])); __builtin_assume(!__builtin_amdgcn_is_private((const void*)p.in[i])); }
    __builtin_assume(!__builtin_amdgcn_is_shared((const void*)p.out)); __builtin_assume(!__builtin_amdgcn_is_private((const void*)p.out));
    __builtin_assume(!__builtin_amdgcn_is_shared((const void*)p.ws)); __builtin_assume(!__builtin_amdgcn_is_private((const void*)p.ws));
#endif
    extern __shared__ __attribute__((aligned(16))) unsigned char lds_raw[];
    LAS unsigned char* lds = (LAS unsigned char*)lds_raw;
    cg::grid_group grid = cg::this_grid();
    unsigned char* ws = p.ws;
    const int G = gridDim.x, bx = blockIdx.x;
    bf16_t* XB = (bf16_t*)(ws + O_XB); float* XF = (float*)(ws + O_XF); bf16_t* ACT = (bf16_t*)(ws + O_ACT);
    const int ph_lo = p.ph_lo, ph_hi = p.ph_hi;
    volatile LAS unsigned* stw = (volatile LAS unsigned*)(lds + LDS_CTL + 16);
    if (threadIdx.x < 2) stw[threadIdx.x] = 0u;
    __syncthreads();
    const XcdBarrier bar = xcd_barrier_post((unsigned*)(ws + O_BAR), stw);
    if (ph_lo < 0) grid.sync();
    {
        {
#define CASE(k) if (PH_ON(k) && ph_lo <= (k) && (k) < ph_hi)
#define SEAM(k) if (ph_lo <= (k) && (k) < ph_hi && ph_hi - ph_lo > 1) xcd_barrier(bar);
        for (int rep0 = 0; rep0 <= REP0; ++rep0) { CASE(0) phase_prep(p, lds); if (rep0 < REP0) grid.sync(); } SEAM(0)
        CASE(1) {
            { const int col = bx * 512 + threadIdx.x;
              if (col < NC12) { float s1 = 0.f, s2 = 0.f;
                  for (int kb = 0; kb < 16; ++kb) { s1 += ((const float*)(ws + O_C1P))[(size_t)kb * NC12 + col]; s2 += ((const float*)(ws + O_C2P))[(size_t)kb * NC12 + col]; }
                  ((float*)(ws + O_C1))[col] = s1; ((float*)(ws + O_C2))[col] = s2; } }
            { pg8::Gemm g{XB, (const bf16_t*)(ws + O_WGU1), M, 2 * FF, D, D}; pg8::StaticOrder S; S.init(M, 2 * FF, G, bx); pg8::EpiSwiGLU E{ACT, nullptr, nullptr, nullptr};
              pg8::gemm_phase<pg8::EpiSwiGLU, pg8::StaticOrder, true, true>(lds, g, S, E); }
            { const int off = (((M / 256) * (2 * FF / 256)) % G) & ~7; pg8::Gemm g{(const bf16_t*)(ws + O_MEMB), (const bf16_t*)(ws + O_WKV), 4096, 2 * D, D, D}; pg8::StaticOrder S; S.init(4096, 2 * D, G, (bx - off + G) % G);
              pg8::EpiMem E{p.out + OUT_MK, p.out + OUT_MV, (bf16_t*)(ws + O_MKB), (bf16_t*)(ws + O_MVB)};
              pg8::gemm_phase<pg8::EpiMem, pg8::StaticOrder, true, true>(lds, g, S, E); }
        } SEAM(1)
        CASE(2) { pg8::Gemm g{ACT, (const bf16_t*)(ws + O_WDN1), NP, D, FF, FF}; pg8::StaticOrder S; S.init(NP, D, G, bx); pg8::EpiResid E{nullptr, nullptr, M, nullptr, 0.5f, nullptr, nullptr, nullptr, XB, (float*)(ws + O_ST1), XB};
            pg8::gemm_phase<pg8::EpiResid, pg8::StaticOrder, true, true>(lds, g, S, E);
            { pg8::Gemm gs{ACT, (const bf16_t*)(ws + O_WDN1), M, D, 256, FF}; pg8::SplitKOrder SS{11, 256, G, bx}; pg8::EpiPartial EP{(float*)(ws + O_SLAB), 256}; pg8::gemm_phase<pg8::EpiPartial, pg8::SplitKOrder, true, true>(lds, gs, SS, EP); } } SEAM(2)
        CASE(3) sample_reduce<0>((const float*)(ws + O_SLAB), 11, nullptr, nullptr, 0.5f, nullptr, nullptr, nullptr, XB, (float*)(ws + O_ST1), nullptr, nullptr, XB); SEAM(3)
        CASE(4) { pg8::Gemm g{XB, (const bf16_t*)(ws + O_WIN), M, INC, D, D}; pg8::StaticOrder S; S.init(M, INC, G, bx);
            pg8::EpiIn E{(bf16_t*)(ws + O_QB), (bf16_t*)(ws + O_KB), (bf16_t*)(ws + O_VB), (bf16_t*)(ws + O_UB), (bf16_t*)(ws + O_GVF), p.out, 0.125f * LOG2E, (const float*)(ws + O_ST1), (const float*)(ws + O_C1) + C_IN, (const float*)(ws + O_C2) + C_IN, (float*)(ws + O_GST)};
            pg8::gemm_phase<pg8::EpiIn, pg8::StaticOrder, true, true>(lds, g, S, E); } SEAM(4)
        for (int rep5 = 0; rep5 <= REP5; ++rep5)
        CASE(5) {
            float lam;
            { const int lane = threadIdx.x & 63; const float a = wave_sum(p.in[12][lane] * p.in[13][lane]), c = wave_sum(p.in[14][lane] * p.in[15][lane]); lam = expf(a) - expf(c) + 0.2f; }
            unsigned* ctr = (unsigned*)(ws + O_CTR) + 4 * rep5;
            constexpr int NU_S = 128, NU_P = 1024, NU_G = (256 + 32) * 4;
            for (int u0 = queue_next(ctr, lds);;) {
                int u = u0;
                if (u >= NU_S + NU_P + NU_G) break;
                unsigned nxt = 0u; if (threadIdx.x == 0) nxt = atomicAdd(ctr, 1u);
                if (u < NU_S) diff_unit<true>(p, lds, u >> 2, u & 3, 0, lam);
                else if (u < NU_S + NU_P) { u -= NU_S; const int qi = 15 - (u >> 6), bh = u & 63; diff_unit<false>(p, lds, bh >> 2, bh & 3, qi, lam); }
                else { u -= NU_S + NU_P; const int bc = u >> 2, g = u & 3; if (bc < 256) gate_unit(p, lds, bc * 128, 128, g, -1); else gate_unit(p, lds, NP + (bc - 256) * 32, 32, g, bc - 256); }
                u0 = queue_pass(nxt, lds);
            }
            if (rep5 < REP5) grid.sync();
        } SEAM(5)
        CASE(6) { pg8::Gemm g{(const bf16_t*)(ws + O_MIX), (const bf16_t*)(ws + O_WOUT), NP, D, D, D}; pg8::StaticOrder S; S.init(NP, D, G, bx);
            pg8::EpiResid E{nullptr, nullptr, M, nullptr, 1.f, (const float*)(ws + O_ST1), p.in[9], p.in[10], XB, (float*)(ws + O_ST2), XB};
            pg8::gemm_phase<pg8::EpiResid, pg8::StaticOrder, true, true>(lds, g, S, E);
            { pg8::Gemm gs{(const bf16_t*)(ws + O_MIX), (const bf16_t*)(ws + O_WOUT), M, D, 256, D}; pg8::SplitKOrder SS{4, 256, G, bx}; pg8::EpiPartial EP{(float*)(ws + O_SLAB), 256}; pg8::gemm_phase<pg8::EpiPartial, pg8::SplitKOrder, true, true>(lds, gs, SS, EP); }
            { const int nb = 16 * 4 < G ? 16 * 4 : 0; if (bx >= nb) cvt_rows(p.in[4], (bf16_t*)(ws + O_MKB) + (size_t)4096 * D, (size_t)8192 * D / 8, (size_t)(bx - nb) * 512 + threadIdx.x, (size_t)(G - nb) * 512); } } SEAM(6)
        CASE(7) sample_reduce<0>((const float*)(ws + O_SLAB), 4, nullptr, nullptr, 1.f, (const float*)(ws + O_ST1), p.in[9], p.in[10], XB, (float*)(ws + O_ST2), nullptr, nullptr, XB); SEAM(7)
        CASE(8) { pg8::Gemm g{XB, (const bf16_t*)(ws + O_WQ), NP, D, D, D}; pg8::StaticOrder S; S.init(NP, D, G, bx); pg8::EpiBf16 E{(bf16_t*)(ws + O_QC), D, 0.0625f * LOG2E, (const float*)(ws + O_ST2), (const float*)(ws + O_C1) + C_Q, (const float*)(ws + O_C2) + C_Q};
            pg8::gemm_phase<pg8::EpiBf16, pg8::StaticOrder, true, true>(lds, g, S, E);
            { pg8::Gemm gs{XB, (const bf16_t*)(ws + O_WQ), M, D, 256, D}; pg8::SplitKOrder SS{4, 256, G, bx}; pg8::EpiPartial EP{(float*)(ws + O_SLAB), 256}; pg8::gemm_phase<pg8::EpiPartial, pg8::SplitKOrder, true, true>(lds, gs, SS, EP); }
            { const int nb = 16 * 4 < G ? 16 * 4 : 0; if (bx >= nb) cvt_rows(p.in[5], (bf16_t*)(ws + O_MVB) + (size_t)4096 * D, (size_t)8192 * D / 8, (size_t)(bx - nb) * 512 + threadIdx.x, (size_t)(G - nb) * 512); } } SEAM(8)
        CASE(15) sample_reduce<1>((const float*)(ws + O_SLAB), 4, nullptr, nullptr, 0.0625f * LOG2E, (const float*)(ws + O_ST2), nullptr, nullptr, (bf16_t*)(ws + O_QC), nullptr, (const float*)(ws + O_C1) + C_Q, (const float*)(ws + O_C2) + C_Q); SEAM(15)
        for (int rep9 = 0; rep9 <= REP9; ++rep9)
        CASE(9) {
            unsigned* ctr = (unsigned*)(ws + O_CTR) + 16 + 4 * rep9;
            constexpr int NU_P = 16 * 4 * 16, NU_S = 32 * 4;
            for (int u0 = queue_next(ctr, lds);;) {
                int u = u0;
                if (u >= NU_P + NU_S) break;
                unsigned nxt = 0u; if (threadIdx.x == 0) nxt = atomicAdd(ctr, 1u);
                if (u < NU_P) cross_unit(p, lds, u >> 6, (u >> 4) & 3, u & 15);
                else { u -= NU_P; cross_unit(p, lds, 16 + (u >> 2), u & 3, 0); }
                u0 = queue_pass(nxt, lds);
            }
            if (rep9 < REP9) grid.sync();
        } SEAM(9)
        CASE(10) { pg8::Gemm g{(const bf16_t*)(ws + O_OC), (const bf16_t*)(ws + O_WO), NP, D, D, D}; pg8::StaticOrder S; S.init(NP, D, G, bx);
            pg8::EpiResid E{nullptr, nullptr, M, nullptr, 1.f, (const float*)(ws + O_ST2), p.in[22], p.in[23], XB, (float*)(ws + O_ST3), XB};
            pg8::gemm_phase<pg8::EpiResid, pg8::StaticOrder, true, true>(lds, g, S, E);
            { pg8::Gemm gs{(const bf16_t*)(ws + O_OC), (const bf16_t*)(ws + O_WO), M, D, 256, D}; pg8::SplitKOrder SS{4, 256, G, bx}; pg8::EpiPartial EP{(float*)(ws + O_SLAB), 256}; pg8::gemm_phase<pg8::EpiPartial, pg8::SplitKOrder, true, true>(lds, gs, SS, EP); } } SEAM(10)
        CASE(11) sample_reduce<0>((const float*)(ws + O_SLAB), 4, nullptr, nullptr, 1.f, (const float*)(ws + O_ST2), p.in[22], p.in[23], XB, (float*)(ws + O_ST3), nullptr, nullptr, XB); SEAM(11)
        for (int rep12 = 0; rep12 <= REP12; ++rep12)
        CASE(12) { pg8::Gemm g{XB, (const bf16_t*)(ws + O_WGU2), M, 2 * FF, D, D}; pg8::StaticOrder S; S.init(M, 2 * FF, G, bx);
            pg8::EpiSwiGLU E{ACT, (const float*)(ws + O_ST3), (const float*)(ws + O_C1) + C_GU2, (const float*)(ws + O_C2) + C_GU2};
            pg8::gemm_phase<pg8::EpiSwiGLU, pg8::StaticOrder, true, true>(lds, g, S, E); if (rep12 < REP12) grid.sync(); } SEAM(12)
        CASE(13) { pg8::Gemm g{ACT, (const bf16_t*)(ws + O_WDN2), NP, D, FF, FF}; pg8::StaticOrder S; S.init(NP, D, G, bx);
            pg8::EpiResid E{nullptr, nullptr, M, nullptr, 0.5f, (const float*)(ws + O_ST3), p.in[28], p.in[29], XB, nullptr, XB};
            pg8::gemm_phase<pg8::EpiResid, pg8::StaticOrder, true, true>(lds, g, S, E);
            { pg8::Gemm gs{ACT, (const bf16_t*)(ws + O_WDN2), M, D, 256, FF}; pg8::SplitKOrder SS{11, 256, G, bx}; pg8::EpiPartial EP{(float*)(ws + O_SLAB), 256}; pg8::gemm_phase<pg8::EpiPartial, pg8::SplitKOrder, true, true>(lds, gs, SS, EP); } } SEAM(13)
        CASE(16) sample_reduce<0>((const float*)(ws + O_SLAB), 11, nullptr, nullptr, 0.5f, (const float*)(ws + O_ST3), p.in[28], p.in[29], XB, nullptr, nullptr, nullptr, XB); SEAM(16)
        CASE(14) phase_ln(XB, p.out + OUT_Y, nullptr, p.in[32], p.in[33]);
        }
    }
}

extern "C" void kernel_launch(void* const* d_in, const int* in_sizes, int n_in, void* d_out, int out_size, void* d_ws, size_t ws_size, hipStream_t stream) {
    static int grid = 0;
    if (grid == 0) {
        if (n_in != 34 || ws_size < O_END) { fprintf(stderr, "kernel_launch: unexpected problem (n_in %d, ws %zu < %zu)\n", n_in, ws_size, (size_t)O_END); grid = -1; return; }
        int dev = 0, cus = 0, per_cu = 0;
        hipGetDevice(&dev);
        hipDeviceGetAttribute(&cus, hipDeviceAttributeMultiprocessorCount, dev);
        if (hipFuncSetAttribute((const void*)mega, hipFuncAttributeMaxDynamicSharedMemorySize, LDS_BYTES) != hipSuccess) { fprintf(stderr, "kernel_launch: hipFuncSetAttribute failed\n"); grid = -1; return; }
        if (hipOccupancyMaxActiveBlocksPerMultiprocessor(&per_cu, (const void*)mega, 512, LDS_BYTES) != hipSuccess || per_cu < 1) { fprintf(stderr, "kernel_launch: occupancy query says %d\n", per_cu); per_cu = 1; }
        (void)hipGetLastError();
        grid = cus * 1;
    }
    if (grid < 0) return;
    Params p{};
    for (int i = 0; i < 34; ++i) p.in[i] = (const float*)d_in[i];
    p.out = (float*)d_out; p.ws = (unsigned char*)d_ws;
    if (hipMemsetAsync((char*)d_ws + O_BAR, 0, 16384, stream) != hipSuccess) { fprintf(stderr, "kernel_launch: memset of the barrier words failed\n"); return; }
#if ONE_LAUNCH
    p.ph_lo = 0; p.ph_hi = NPH;
    void* args[] = {&p};
    hipError_t e = hipLaunchCooperativeKernel((const void*)mega, dim3(grid), dim3(512), args, LDS_BYTES, stream);
    if (e != hipSuccess) fprintf(stderr, "cooperative launch failed: %s (grid %d)\n", hipGetErrorString(e), grid);
#else
    static const int order[NPH] = {0, 1, 2, 3, 4, 5, 6, 7, 8, 15, 9, 10, 11, 12, 13, 16, 14};
    for (int pi = 0; pi < NPH; ++pi) { const int ph = order[pi]; p.ph_lo = ph; p.ph_hi = ph + 1; hipLaunchKernelGGL(mega, dim3(grid), dim3(512), LDS_BYTES, stream, p); }
#endif
}
```
